# Optimizing an MI355X kernel written in HIP

```python
import math
import jax
import jax.numpy as jnp
from jax import lax
import numpy as np

D_MODEL = 2048
BATCH = 8
SEQ = 4096
DEPTH = 4

ATT_PATTERNS = ((128, 1), (512, 4), (2048, 16))
N_GROUPS_A = len(ATT_PATTERNS)
HEADS_PER_GROUP = 8
HEAD_DIM = 64
N_HEADS_A = N_GROUPS_A * HEADS_PER_GROUP
QKV_WIDTH_A = N_HEADS_A * HEAD_DIM
WIDTH_A = HEADS_PER_GROUP * HEAD_DIM
ATT_BLOCK = 128
N_REL_BUCKETS = 32
REL_MAX_DIST = 2048
NEG_INF = -1e30
CHUNK = 128
WIDTH_B = 768
N_GROUPS_B = 6
GROUP_B = WIDTH_B // N_GROUPS_B
WIDTH_C = 768
SSM_GROUP = 16
N_GROUPS_C = WIDTH_C // SSM_GROUP
SSM_STATE = 64
DT_MIN = 1e-3
DT_MAX = 1e-1
N_BRANCH = 3
D_FF = -(-8 * D_MODEL // (3 * 256)) * 256
ALPHA = (2 * DEPTH) ** 0.25
BETA = (8 * DEPTH) ** -0.25
IN_SPLIT = (QKV_WIDTH_A, QKV_WIDTH_A, QKV_WIDTH_A, 2 * WIDTH_B, WIDTH_C, N_BRANCH * D_MODEL)
IN_COLS = sum(IN_SPLIT)

kernel_name = 'hybrid_dilated_attn_gmlp_s5_deepnorm'


def _layer_norm(x, g, b, eps=1e-5):
    xf = x.astype(jnp.float32)
    mu = jnp.mean(xf, axis=-1, keepdims=True)
    var = jnp.mean(jnp.square(xf - mu), axis=-1, keepdims=True)
    return ((xf - mu) * lax.rsqrt(var + eps) * g + b).astype(x.dtype)


def _t5_bucket(dist):
    max_exact = N_REL_BUCKETS // 2
    d = np.maximum(dist, 1).astype(np.float32)
    scale = (N_REL_BUCKETS - max_exact) / math.log(REL_MAX_DIST / max_exact)
    large = max_exact + (np.log(d / max_exact) * scale).astype(np.int32)
    large = np.minimum(large, N_REL_BUCKETS - 1)
    return np.where(dist < max_exact, dist, large).astype(np.int32)


def _band_steps():
    i = np.arange(ATT_BLOCK)[:, None]
    kk = np.arange(2 * ATT_BLOCK)[None, :]
    return ATT_BLOCK + i - kk


def _group_rel_bias(rel_bias, g, dilation):
    bucket = _t5_bucket(np.maximum(_band_steps(), 0) * dilation)
    cols = rel_bias[:, g * HEADS_PER_GROUP:(g + 1) * HEADS_PER_GROUP]
    return jnp.transpose(cols[bucket], (2, 0, 1)).astype(jnp.float32)


def _dilated_window_attention(q, k, v, bias, dilation, n_steps):
    bsz, s, h, hd = q.shape
    L = s // dilation
    nb = -(-L // ATT_BLOCK)
    lp = nb * ATT_BLOCK

    def to_streams(t):
        t = t.reshape(bsz, L, dilation, h, hd).transpose(0, 2, 1, 3, 4)
        return jnp.pad(t, ((0, 0), (0, 0), (0, lp - L), (0, 0), (0, 0)))

    def to_band(t):
        t = jnp.pad(t, ((0, 0), (0, 0), (ATT_BLOCK, 0), (0, 0), (0, 0)))
        t = t.reshape(bsz, dilation, nb + 1, ATT_BLOCK, h, hd)
        return jnp.concatenate([t[:, :, :-1], t[:, :, 1:]], axis=3)

    qb = to_streams(q).reshape(bsz, dilation, nb, ATT_BLOCK, h, hd)
    kb = to_band(to_streams(k))
    vb = to_band(to_streams(v))
    steps = _band_steps()
    key_idx = (np.arange(nb)[:, None] - 1) * ATT_BLOCK + np.arange(2 * ATT_BLOCK)[None, :]
    mask = ((steps >= 0) & (steps <= n_steps))[None, None] & (key_idx >= 0)[:, None, None, :]
    logits = jnp.einsum('brnqhd,brnkhd->brnhqk', qb, kb, preferred_element_type=jnp.float32)
    logits = jnp.where(mask, logits * (hd ** -0.5) + bias, NEG_INF)
    m = jnp.max(logits, axis=-1, keepdims=True)
    p = jnp.exp(logits - m)
    den = jnp.sum(p, axis=-1, keepdims=True)
    o = jnp.einsum('brnhqk,brnkhd->brnqhd', p, vb.astype(jnp.float32)) / jnp.swapaxes(den, 3, 4)
    lse = jnp.swapaxes((m + jnp.log(den))[..., 0], 3, 4)
    o = o.reshape(bsz, dilation, lp, h, hd)[:, :, :L].transpose(0, 2, 1, 3, 4).reshape(bsz, s, h, hd)
    lse = lse.reshape(bsz, dilation, lp, h)[:, :, :L].transpose(0, 2, 1, 3).reshape(bsz, s, h)
    return o, lse


def _spatial_gating(z, ln_g, ln_b, w_s, b_s):
    bsz, s, _ = z.shape
    u, v = jnp.split(z, 2, axis=-1)
    v = _layer_norm(v, ln_g, ln_b)
    vc = v.reshape(bsz, s // CHUNK, CHUNK, N_GROUPS_B, GROUP_B)
    w = jnp.tril(w_s)
    mixed = jnp.einsum('gts,bnsgc->bntgc', w, vc) + jnp.transpose(b_s)[:, :, None]
    return u * mixed.reshape(bsz, s, WIDTH_B)


def _ssm_combine(e1, e2):
    a1r, a1i, b1r, b1i = e1
    a2r, a2i, b2r, b2i = e2
    return (a2r * a1r - a2i * a1i,
            a2r * a1i + a2i * a1r,
            a2r * b1r - a2i * b1i + b2r,
            a2r * b1i + a2i * b1r + b2i)


def _s5(u, lam_re, lam_im, log_dt, b_re, b_im, c_re, c_im, d_skip):
    bsz, s, _ = u.shape
    f32 = jnp.float32
    uf = u.astype(f32)
    ug = uf.reshape(bsz, s, N_GROUPS_C, SSM_GROUP)
    lr = lam_re.astype(f32)
    li = lam_im.astype(f32)
    dt = jnp.exp(log_dt.astype(f32))[:, None]
    mag = jnp.exp(lr * dt)
    ab_re = mag * jnp.cos(li * dt)
    ab_im = mag * jnp.sin(li * dt)
    nrm = lr * lr + li * li
    cr = ((ab_re - 1.0) * lr + ab_im * li) / nrm
    ci = (ab_im * lr - (ab_re - 1.0) * li) / nrm
    bb_re = cr[..., None] * b_re - ci[..., None] * b_im
    bb_im = cr[..., None] * b_im + ci[..., None] * b_re
    bu_re = jnp.einsum('bsgh,gph->bsgp', ug, bb_re.astype(f32))
    bu_im = jnp.einsum('bsgh,gph->bsgp', ug, bb_im.astype(f32))
    a_re = jnp.broadcast_to(ab_re[None, None], (1, s, N_GROUPS_C, SSM_STATE))
    a_im = jnp.broadcast_to(ab_im[None, None], (1, s, N_GROUPS_C, SSM_STATE))
    _, _, xr, xi = lax.associative_scan(_ssm_combine, (a_re, a_im, bu_re, bu_im), axis=1)
    y = (jnp.einsum('bsgp,ghp->bsgh', xr, c_re.astype(f32))
         - jnp.einsum('bsgp,ghp->bsgh', xi, c_im.astype(f32)))
    return y.reshape(bsz, s, WIDTH_C) + d_skip.astype(f32) * uf


def setup_inputs(seed: int = 0) -> dict:
    key = jax.random.key(seed)
    ks = iter(jax.random.split(key, 32))
    nrm = lambda shape, scale: jax.random.normal(next(ks), shape, jnp.float32) * scale
    gain = lambda shape: 1.0 + nrm(shape, 0.02)
    n_idx = jnp.arange(SSM_STATE, dtype=jnp.float32)
    return {
        'x': nrm((BATCH, SEQ, D_MODEL), 1.0),
        'w_in': nrm((DEPTH, D_MODEL, IN_COLS), D_MODEL ** -0.5),
        'b_in': nrm((DEPTH, IN_COLS), 0.02),
        'rel_bias': nrm((N_REL_BUCKETS, N_HEADS_A), 0.1),
        'sgu_ln_g': gain((DEPTH, WIDTH_B)),
        'sgu_ln_b': nrm((DEPTH, WIDTH_B), 0.02),
        'w_s': nrm((DEPTH, N_GROUPS_B, CHUNK, CHUNK), CHUNK ** -0.5),
        'b_s': gain((DEPTH, N_GROUPS_B, CHUNK)),
        'lam_re': -0.5 + nrm((DEPTH, N_GROUPS_C, SSM_STATE), 0.01),
        'lam_im': math.pi * n_idx + nrm((DEPTH, N_GROUPS_C, SSM_STATE), 0.01),
        'log_dt': jax.random.uniform(next(ks), (DEPTH, N_GROUPS_C), jnp.float32,
                                     minval=math.log(DT_MIN), maxval=math.log(DT_MAX)),
        'b_re': nrm((DEPTH, N_GROUPS_C, SSM_STATE, SSM_GROUP), (2 * SSM_GROUP) ** -0.5),
        'b_im': nrm((DEPTH, N_GROUPS_C, SSM_STATE, SSM_GROUP), (2 * SSM_GROUP) ** -0.5),
        'c_re': nrm((DEPTH, N_GROUPS_C, SSM_GROUP, SSM_STATE), SSM_STATE ** -0.5),
        'c_im': nrm((DEPTH, N_GROUPS_C, SSM_GROUP, SSM_STATE), SSM_STATE ** -0.5),
        'd_skip': nrm((DEPTH, WIDTH_C), 1.0),
        'w_glu': nrm((DEPTH, WIDTH_C, WIDTH_C), WIDTH_C ** -0.5),
        'b_glu': nrm((DEPTH, WIDTH_C), 0.02),
        'w_pa': nrm((DEPTH, WIDTH_A, D_MODEL), WIDTH_A ** -0.5),
        'w_pb': nrm((DEPTH, WIDTH_B, D_MODEL), WIDTH_B ** -0.5),
        'w_pc': nrm((DEPTH, WIDTH_C, D_MODEL), WIDTH_C ** -0.5),
        'w_o': nrm((DEPTH, D_MODEL, D_MODEL), BETA * D_MODEL ** -0.5),
        'ln1_g': gain((DEPTH, D_MODEL)),
        'ln1_b': nrm((DEPTH, D_MODEL), 0.02),
        'w_ffn_in': nrm((DEPTH, D_MODEL, 2 * D_FF), D_MODEL ** -0.5),
        'w_ffn_out': nrm((DEPTH, D_FF, D_MODEL), BETA * D_FF ** -0.5),
        'ln2_g': gain((DEPTH, D_MODEL)),
        'ln2_b': nrm((DEPTH, D_MODEL), 0.02),
    }


def reference(x, w_in, b_in, rel_bias, sgu_ln_g, sgu_ln_b, w_s, b_s, lam_re, lam_im, log_dt,
              b_re, b_im, c_re, c_im, d_skip, w_glu, b_glu, w_pa, w_pb, w_pc, w_o,
              ln1_g, ln1_b, w_ffn_in, w_ffn_out, ln2_g, ln2_b):
    dt = x.dtype
    bsz, s, _ = x.shape
    offs = np.cumsum(IN_SPLIT)[:-1].tolist()
    group_bias = [_group_rel_bias(rel_bias, g, dil) for g, (_, dil) in enumerate(ATT_PATTERNS)]
    for l in range(DEPTH):
        proj = x @ w_in[l] + b_in[l]
        q, k, v, zb, uc, gl = jnp.split(proj, offs, axis=-1)
        q = q.reshape(bsz, s, N_HEADS_A, HEAD_DIM)
        k = k.reshape(bsz, s, N_HEADS_A, HEAD_DIM)
        v = v.reshape(bsz, s, N_HEADS_A, HEAD_DIM)
        outs, lses = [], []
        for g, (window, dil) in enumerate(ATT_PATTERNS):
            sl = slice(g * HEADS_PER_GROUP, (g + 1) * HEADS_PER_GROUP)
            o_g, lse_g = _dilated_window_attention(q[:, :, sl], k[:, :, sl], v[:, :, sl],
                                                   group_bias[g], dil, window // dil)
            outs.append(o_g)
            lses.append(lse_g)
        wts = jax.nn.softmax(jnp.stack(lses, axis=0), axis=0)
        ya = jnp.sum(wts[..., None] * jnp.stack(outs, axis=0), axis=0)
        ya = ya.reshape(bsz, s, WIDTH_A).astype(dt)
        yb = _spatial_gating(jax.nn.gelu(zb), sgu_ln_g[l], sgu_ln_b[l], w_s[l], b_s[l]).astype(dt)
        yc = jax.nn.gelu(_s5(uc, lam_re[l], lam_im[l], log_dt[l], b_re[l], b_im[l],
                             c_re[l], c_im[l], d_skip[l]))
        yc = (yc * jax.nn.sigmoid(yc @ w_glu[l] + b_glu[l])).astype(dt)
        gates = jax.nn.sigmoid(gl.reshape(bsz, s, N_BRANCH, D_MODEL))
        merged = (gates[:, :, 0] * (ya @ w_pa[l]) + gates[:, :, 1] * (yb @ w_pb[l])
                  + gates[:, :, 2] * (yc @ w_pc[l]))
        x = _layer_norm(ALPHA * x + merged @ w_o[l], ln1_g[l], ln1_b[l]).astype(dt)
        gate_f, up = jnp.split(x @ w_ffn_in[l], 2, axis=-1)
        f = (jax.nn.silu(gate_f) * up) @ w_ffn_out[l]
        x = _layer_norm(ALPHA * x + f, ln2_g[l], ln2_b[l]).astype(dt)
    return x
```

```cpp
#include <hip/hip_runtime.h>
#include <cstdio>
#include <cstdint>

#ifndef MK_MULTI
#define MK_MULTI 0
#endif

#define GAS __attribute__((address_space(1)))
#define LAS __attribute__((address_space(3)))
typedef unsigned short bf16_t;
typedef short bf16x8 __attribute__((ext_vector_type(8)));
typedef float f32x4 __attribute__((ext_vector_type(4)));
typedef float f32x2 __attribute__((ext_vector_type(2)));
typedef float f32x16 __attribute__((ext_vector_type(16)));
typedef unsigned u32x4 __attribute__((ext_vector_type(4)));
typedef unsigned u32x2 __attribute__((ext_vector_type(2)));

constexpr int DM = 2048, BATCH = 8, SEQ = 4096, DEPTH = 4, MTOK = BATCH * SEQ;
constexpr int NCOLS_IN = 13056, DFF = 5632;
constexpr float ALPHA = 1.681792830507429f;
constexpr float LN_EPS = 1e-5f;
constexpr float LOG2E = 1.4426950408889634f, LN2 = 0.6931471805599453f;
constexpr int NPH = 14;

__device__ const unsigned char T5B[3][129] = {
 {0,1,2,3,4,5,6,7,8,9,10,11,12,13,14,15,16,16,16,16,16,16,17,17,17,17,17,17,17,17,18,18,18,18,18,18,18,18,18,18,19,19,19,19,19,19,19,19,19,19,19,19,19,19,20,20,20,20,20,20,20,20,20,20,20,20,20,20,20,20,20,20,20,21,21,21,21,21,21,21,21,21,21,21,21,21,21,21,21,21,21,21,21,21,21,21,21,21,21,22,22,22,22,22,22,22,22,22,22,22,22,22,22,22,22,22,22,22,22,22,22,22,22,22,22,22,22,22,22},
 {0,4,8,12,16,16,17,17,18,18,19,19,19,19,20,20,20,20,20,21,21,21,21,21,21,22,22,22,22,22,22,22,22,22,23,23,23,23,23,23,23,23,23,23,23,23,24,24,24,24,24,24,24,24,24,24,24,24,24,24,24,24,25,25,25,25,25,25,25,25,25,25,25,25,25,25,25,25,25,25,25,25,25,26,26,26,26,26,26,26,26,26,26,26,26,26,26,26,26,26,26,26,26,26,26,26,26,26,26,26,26,26,26,27,27,27,27,27,27,27,27,27,27,27,27,27,27,27,27},
 {0,16,18,19,20,21,21,22,22,23,23,23,24,24,24,24,25,25,25,25,25,26,26,26,26,26,26,26,26,27,27,27,27,27,27,27,27,27,27,28,28,28,28,28,28,28,28,28,28,28,28,28,29,29,29,29,29,29,29,29,29,29,29,29,29,29,29,29,29,29,30,30,30,30,30,30,30,30,30,30,30,30,30,30,30,30,30,30,30,30,30,30,30,30,30,31,31,31,31,31,31,31,31,31,31,31,31,31,31,31,31,31,31,31,31,31,31,31,31,31,31,31,31,31,31,31,31,31,31}};

typedef __bf16 bf16x2_t __attribute__((ext_vector_type(2)));
__device__ __forceinline__ unsigned cvt_pk_bf16(float lo, float hi) { const f32x2 v = {lo, hi}; return __builtin_bit_cast(unsigned, __builtin_convertvector(v, bf16x2_t)); }
__device__ __forceinline__ float bf_lo(unsigned w) { return __uint_as_float(w << 16); }
__device__ __forceinline__ float bf_hi(unsigned w) { return __uint_as_float(w & 0xffff0000u); }
__device__ __forceinline__ float fast_sigmoid(float x) { return __builtin_amdgcn_rcpf(1.0f + __builtin_amdgcn_exp2f(-LOG2E * x)); }
__device__ __forceinline__ float gelu_tanh(float x) {
    const float u = x * (1.0f + 0.044715f * x * x);
    return x * __builtin_amdgcn_rcpf(1.0f + __builtin_amdgcn_exp2f(-2.0f * 0.7978845608028654f * LOG2E * u));
}
__device__ __forceinline__ float silu(float x) { return x * fast_sigmoid(x); }
__device__ __forceinline__ void unpack8(const u32x4 w, float (&f)[8]) {
    f[0] = bf_lo(w.x); f[1] = bf_hi(w.x); f[2] = bf_lo(w.y); f[3] = bf_hi(w.y); f[4] = bf_lo(w.z); f[5] = bf_hi(w.z); f[6] = bf_lo(w.w); f[7] = bf_hi(w.w);
}
__device__ __forceinline__ u32x4 pack8(const float (&f)[8]) {
    u32x4 w; w.x = cvt_pk_bf16(f[0], f[1]); w.y = cvt_pk_bf16(f[2], f[3]); w.z = cvt_pk_bf16(f[4], f[5]); w.w = cvt_pk_bf16(f[6], f[7]); return w;
}
__device__ __forceinline__ float shfl_xor_l(float v, int o, int lane) { return __int_as_float(__builtin_amdgcn_ds_bpermute((lane ^ o) << 2, __float_as_int(v))); }
__device__ __forceinline__ float wave_sum(float v, int lane) {
#pragma unroll
    for (int o = 1; o < 64; o <<= 1) v += shfl_xor_l(v, o, lane);
    return v;
}

namespace pg8 {
constexpr int BM = 256, BK = 64, HALF = 128, HTB = HALF * BK * 2, STAGE_BYTES = 8 * HTB, NXCD = 8, WGM = 8;
__host__ __device__ __forceinline__ int lds_byte(int r, int c) { const int st = (r >> 4) * 2 + (c >> 5), rr = r & 15, cc = c & 31, ob = rr * 64 + cc * 2; return st * 1024 + (ob ^ (((ob >> 9) & 1) << 5)); }
__host__ __device__ __forceinline__ void stage_rc(int b, int& R, int& C) { const int st = b / 1024, sb = b % 1024, swz = sb ^ (((sb >> 9) & 1) << 5); R = (st >> 1) * 16 + swz / 64; C = (st & 1) * 32 + (swz % 64) / 2; }
__host__ __device__ __forceinline__ int perm32(int rho) { const int n = rho >> 4, i = rho & 15; return 8 * (i >> 2) + 4 * n + (i & 3); }

struct Unit { int pm, pn, g; };
struct OpDesc { unsigned rs, ks; int cshift; unsigned cstride; };
__device__ __forceinline__ OpDesc dense_op(int K) { OpDesc d; d.rs = (unsigned)K * 2u; d.ks = 128u; d.cshift = 6; d.cstride = 0u; return d; }
__device__ __forceinline__ unsigned op_off(const OpDesc& d, int R, int C) { return (unsigned)R * d.rs + (unsigned)(C >> d.cshift) * d.cstride + (unsigned)(C & ((1 << d.cshift) - 1)) * 2u; }

template <class Epi, class Sched>
__device__ __forceinline__ void gemm_phase(const int tid_in, LAS unsigned char* lds, const int K, const OpDesc dA, const OpDesc dB, const Sched& S, const Epi& E) {
    int tid = tid_in; asm volatile("" : "+v"(tid));
    const int wid = __builtin_amdgcn_readfirstlane(tid >> 6), lane = tid & 63, wr = wid >> 2, wc = wid & 3, fr = lane & 15, fq = lane >> 4;
    const int nt = K / BK;
    unsigned voffA[2], voffB[2];
#pragma unroll
    for (int i = 0; i < 2; ++i) { int R, C; stage_rc(tid * 16 + i * 8192, R, C); const int Rb = Epi::PERM ? ((R & ~31) + perm32(R & 31)) : R;
        voffA[i] = op_off(dA, R, C); voffB[i] = op_off(dB, Rb, C); }
    const size_t kstepA = dA.ks, kstepB = dB.ks;
    const size_t hstepA = (size_t)HALF * dA.rs, hstepB = (size_t)HALF * dB.rs;
    const unsigned ldsw = (unsigned)wid * 1024u;
    const int aoff = lds_byte(wr * 64 + fr, fq * 8), boff = lds_byte(wc * 32 + fr, fq * 8);
#define PG8_SA(b, h) (((b) * 2 + (h)) * HTB)
#define PG8_SB(b, h) ((4 + (b) * 2 + (h)) * HTB)
#define PG8_STAGE(bufoff, gbase, voff) do { _Pragma("unroll") for (int _i = 0; _i < 2; ++_i) \
        __builtin_amdgcn_global_load_lds((const unsigned*)((const char*)(gbase) + (voff)[_i]), (LAS unsigned*)(lds + (bufoff) + ldsw + _i * 8192), 16, 0, 0); } while (0)
#define PG8_LDA(dst, b, h) do { _Pragma("unroll") for (int m = 0; m < 4; ++m) _Pragma("unroll") for (int k = 0; k < 2; ++k) dst[m][k] = *(const LAS bf16x8*)(lds + PG8_SA(b, h) + aoff + m * 2048 + k * 1024); } while (0)
#define PG8_LDB(dst, b, h) do { _Pragma("unroll") for (int n = 0; n < 2; ++n) _Pragma("unroll") for (int k = 0; k < 2; ++k) dst[n][k] = *(const LAS bf16x8*)(lds + PG8_SB(b, h) + boff + n * 2048 + k * 1024); } while (0)
#define PG8_MMA(ai, bj, At, Bt) do { __builtin_amdgcn_s_setprio(1); _Pragma("unroll") for (int m = 0; m < 4; ++m) _Pragma("unroll") for (int n = 0; n < 2; ++n) _Pragma("unroll") for (int k = 0; k < 2; ++k) \
        acc[ai][bj][m][n] = __builtin_amdgcn_mfma_f32_16x16x32_bf16(Bt[n][k], At[m][k], acc[ai][bj][m][n], 0, 0, 0); __builtin_amdgcn_s_setprio(0); } while (0)
#define PG8_WAIT_V(n) asm volatile("s_waitcnt vmcnt(" #n ")" ::: "memory")
#define PG8_WAIT_L(n) asm volatile("s_waitcnt lgkmcnt(" #n ")" ::: "memory")
#define PG8_BAR __builtin_amdgcn_s_barrier()
#define PG8_SCHED __builtin_amdgcn_sched_barrier(0)
    Unit cur, nxt; int ui = 0;
    if (!S.next(0, cur)) return;
    f32x4 acc[2][2][4][2];
#pragma unroll
    for (int a = 0; a < 2; ++a)
#pragma unroll
        for (int b = 0; b < 2; ++b)
#pragma unroll
            for (int m = 0; m < 4; ++m)
#pragma unroll
                for (int n = 0; n < 2; ++n) acc[a][b][m][n] = (f32x4){0.f, 0.f, 0.f, 0.f};
    bf16x8 At[4][2], B0[2][2], B1[2][2];
    const char* cA = S.pA(cur); const char* cB = S.pB(cur);
    PG8_STAGE(PG8_SB(0, 0), cB, voffB); PG8_STAGE(PG8_SB(0, 1), cB + hstepB, voffB); PG8_STAGE(PG8_SA(0, 0), cA, voffA); PG8_STAGE(PG8_SA(0, 1), cA + hstepA, voffA);
    if (wr == 1) PG8_BAR;
    PG8_WAIT_V(2); PG8_BAR;
    PG8_STAGE(PG8_SB(1, 0), cB + kstepB, voffB); PG8_STAGE(PG8_SA(1, 0), cA + kstepA, voffA); PG8_STAGE(PG8_SB(1, 1), cB + hstepB + kstepB, voffB);
    PG8_WAIT_V(6); PG8_BAR;
    for (;;) {
        const bool has_next = S.next(ui + 1, nxt);
        const char* nA = has_next ? S.pA(nxt) : cA; const char* nB = has_next ? S.pB(nxt) : cB;
        for (int t = 0; t < nt; t += 2) {
            const bool last = (t == nt - 2);
            const char* a1 = cA + (size_t)(t + 1) * kstepA;
            const char* a2 = last ? nA : cA + (size_t)(t + 2) * kstepA; const char* b2 = last ? nB : cB + (size_t)(t + 2) * kstepB;
            const char* a3 = a2 + kstepA; const char* b3 = b2 + kstepB;
            PG8_LDB(B0, 0, 0); PG8_LDB(B1, 0, 1); PG8_SCHED; PG8_LDA(At, 0, 0); PG8_STAGE(PG8_SA(1, 1), a1 + hstepA, voffA);
            PG8_WAIT_V(8); PG8_WAIT_L(0); PG8_BAR; PG8_MMA(0, 0, At, B0); PG8_MMA(0, 1, At, B1); PG8_BAR; PG8_SCHED;
            PG8_LDA(At, 0, 1); PG8_STAGE(PG8_SB(0, 0), b2, voffB); PG8_STAGE(PG8_SB(0, 1), b2 + hstepB, voffB); PG8_STAGE(PG8_SA(0, 0), a2, voffA);
            PG8_WAIT_V(8); PG8_WAIT_L(0); PG8_BAR; PG8_MMA(1, 0, At, B0); PG8_MMA(1, 1, At, B1); PG8_BAR; PG8_SCHED;
            PG8_LDB(B0, 1, 0); PG8_LDB(B1, 1, 1); PG8_SCHED; PG8_LDA(At, 1, 0); PG8_STAGE(PG8_SA(0, 1), a2 + hstepA, voffA);
            PG8_WAIT_V(8); PG8_WAIT_L(0); PG8_BAR; PG8_MMA(0, 0, At, B0); PG8_MMA(0, 1, At, B1); PG8_BAR; PG8_SCHED;
            PG8_LDA(At, 1, 1); PG8_STAGE(PG8_SB(1, 0), b3, voffB); PG8_STAGE(PG8_SB(1, 1), b3 + hstepB, voffB); PG8_STAGE(PG8_SA(1, 0), a3, voffA);
            PG8_WAIT_V(8); PG8_WAIT_L(0); PG8_BAR; PG8_MMA(1, 0, At, B0); PG8_MMA(1, 1, At, B1); PG8_BAR; PG8_SCHED;
        }
        if (wr == 0) PG8_BAR;
        E(acc, cur, wr, wc, fr, fq);
        if (!has_next) break;
#pragma unroll
        for (int a = 0; a < 2; ++a)
#pragma unroll
            for (int b = 0; b < 2; ++b)
#pragma unroll
                for (int m = 0; m < 4; ++m)
#pragma unroll
                    for (int n = 0; n < 2; ++n) acc[a][b][m][n] = (f32x4){0.f, 0.f, 0.f, 0.f};
        cur = nxt; cA = nA; cB = nB; ++ui;
        if (wr == 1) PG8_BAR;
    }
    PG8_WAIT_V(0);
    PG8_BAR;
#undef PG8_SA
#undef PG8_SB
#undef PG8_STAGE
#undef PG8_LDA
#undef PG8_LDB
#undef PG8_MMA
#undef PG8_WAIT_V
#undef PG8_WAIT_L
#undef PG8_BAR
#undef PG8_SCHED
}

struct DenseSched {
    int nM, nN, nwg, G, c; const char* A; const char* B; size_t tA, tB;
    __device__ void init(const void* A_, const void* B_, int M, int N, int K, int G_, int c_) { nM = M / BM; nN = N / BM; nwg = nM * nN; G = G_; c = c_; A = (const char*)A_; B = (const char*)B_; tA = (size_t)BM * K * 2; tB = tA; }
    __device__ bool next(int i, Unit& u) const {
        const long L = (long)i * G + c; if (L >= nwg) return false;
        int wgid = (int)L; { const int q = nwg / NXCD, r = nwg % NXCD, xcd = wgid % NXCD, off = wgid / NXCD; wgid = (xcd < r ? xcd * (q + 1) : r * (q + 1) + (xcd - r) * q) + off; }
        const int nig = WGM * nN, gid = wgid / nig, fm = gid * WGM, gsz = (nM - fm) < WGM ? (nM - fm) : WGM;
        u.pm = fm + ((wgid % nig) % gsz); u.pn = (wgid % nig) / gsz; u.g = 0; return true;
    }
    __device__ __forceinline__ const char* pA(const Unit& u) const { return A + (size_t)u.pm * tA; }
    __device__ __forceinline__ const char* pB(const Unit& u) const { return B + (size_t)u.pn * tB; }
};
struct SwapSched {
    int nM, nwg, G, c, dil; const char* W; const char* X;
    __device__ bool next(int i, Unit& u) const { const int L = i * G + c; if (L >= nwg) return false; u.pm = L % nM; u.pn = L / nM; u.g = 0; return true; }
    __device__ __forceinline__ const char* pA(const Unit& u) const { return W + (size_t)u.pm * (256 * DM * 2); }
    __device__ __forceinline__ const char* pB(const Unit& u) const {
        const int b = u.pn >> 4, o = (u.pn & 15) * 256, Ls = SEQ / dil, cc = o / Ls, m0 = o % Ls;
        return X + (size_t)(b * SEQ + m0 * dil + cc) * (DM * 2);
    }
};
struct GroupSched {
    int nM, nN, nwg, G, c; const char* A; const char* B; size_t gA, tA, gB, tB;
    __device__ bool next(int i, Unit& u) const { const int L = i * G + c; if (L >= nwg) return false; const int per = nM * nN; u.g = L / per; const int r = L % per; u.pm = r % nM; u.pn = r / nM; return true; }
    __device__ __forceinline__ const char* pA(const Unit& u) const { return A + (size_t)u.g * gA + (size_t)u.pm * tA; }
    __device__ __forceinline__ const char* pB(const Unit& u) const { return B + (size_t)u.g * gB + (size_t)u.pn * tB; }
};
}
using pg8::Unit;

constexpr size_t MiB = 1u << 20;
constexpr size_t WS_CTL = 0, CTL_ZERO_BYTES = 1 * MiB;
constexpr size_t WS_WIN  = 1 * MiB;
constexpr size_t WS_WGLU = WS_WIN + (size_t)NCOLS_IN * DM * 2;
constexpr size_t WS_WPA  = WS_WGLU + 768 * 768 * 2;
constexpr size_t WS_WPB  = WS_WPA + 2048 * 512 * 2;
constexpr size_t WS_WPC  = WS_WPB + 2048 * 768 * 2;
constexpr size_t WS_WO   = WS_WPC + 2048 * 768 * 2;
constexpr size_t WS_WFF1 = WS_WO + (size_t)DM * DM * 2;
constexpr size_t WS_WFF2 = WS_WFF1 + (size_t)2 * DFF * DM * 2;
constexpr size_t WS_MISC = WS_WFF2 + (size_t)DM * DFF * 2;
constexpr size_t MS_BIASR = 0;
constexpr size_t MS_WTRIL = 64 * 1024;
constexpr size_t MS_KJ    = MS_WTRIL + 6 * 128 * 128 * 2;
constexpr size_t MS_END   = MS_KJ + 48 * 64 * 256 * 4;
constexpr size_t WS_S5BT = ((WS_MISC + MS_END + MiB - 1) / MiB) * MiB;
constexpr size_t WS_S5QM = WS_S5BT + (size_t)(48 * 1152 + 128) * 1024 * 2;
constexpr size_t WS_XB   = ((WS_S5QM + (size_t)48 * 1024 * 256 * 2 + MiB - 1) / MiB) * MiB;
constexpr size_t WS_Q    = WS_XB + (size_t)MTOK * DM * 2;
constexpr size_t WS_K    = WS_Q + (size_t)MTOK * 1536 * 2;
constexpr size_t WS_MERGED = WS_Q;
constexpr size_t WS_VT   = WS_K + (size_t)MTOK * 1536 * 2;
constexpr size_t WS_VGT  = WS_VT + (size_t)1536 * MTOK * 2;
constexpr size_t WS_U    = WS_VGT + (size_t)768 * MTOK * 2;
constexpr size_t WS_UC   = WS_U + (size_t)MTOK * 768 * 2;
constexpr size_t WS_GATES = WS_UC + (size_t)MTOK * 768 * 2;
constexpr size_t WS_H    = WS_GATES;
constexpr size_t WS_LSE  = WS_GATES + (size_t)MTOK * 6144 * 2;
constexpr size_t WS_YA   = WS_LSE + (size_t)MTOK * 24 * 4;
constexpr size_t WS_YB   = WS_YA + (size_t)MTOK * 512 * 2;
constexpr size_t WS_YC   = WS_YB + (size_t)MTOK * 768 * 2;
constexpr size_t WS_YC2  = WS_YC + (size_t)MTOK * 768 * 2;
constexpr size_t WS_YI   = WS_YC2 + (size_t)MTOK * 768 * 2;
constexpr size_t WS_E    = WS_YI + (size_t)MTOK * 768 * 2;
constexpr size_t WS_XIN  = WS_E + (size_t)512 * 48 * 128 * 4;
constexpr size_t WS_TAB  = WS_XIN + (size_t)48 * 512 * 256 * 2;
constexpr size_t TAB_PW = 0, TAB_BB = 48 * 64 * 65 * 8, TAB_LAYER = TAB_BB + 48 * 64 * 16 * 8;
constexpr size_t WS_END  = WS_TAB + DEPTH * TAB_LAYER;
static_assert(WS_H + (size_t)MTOK * DFF * 2 <= WS_LSE, "h overlay fits in the gates");
static_assert(WS_MERGED + (size_t)MTOK * DM * 2 <= WS_VT, "merged overlay fits in q|k");

constexpr int CW_TMO = 0, CW_BAR = 4096;
constexpr int RING_OFF = 0, RING_BYTES = 131072, LDSCTL_OFF = RING_BYTES, MISC_OFF = LDSCTL_OFF + 320, LDS_BYTES = 147456;
constexpr int NWAVES = 8;

#define XB_TMO      128
#define XB_XCNT(j)  (256  + 64 * (j))
#define XB_XSUB(j)  (1280 + 64 * (j))
#define XB_XGEN(j)  (2304 + 64 * (j))
#define XB_TOP      3328
#define XB_TOPGEN   3392
#define XCD_BAR_WORDS 3456
#define XB_SPIN_CAP (1u << 18)
__device__ __forceinline__ unsigned xb_ld(unsigned* p)              { return __hip_atomic_load(p, __ATOMIC_RELAXED, __HIP_MEMORY_SCOPE_AGENT); }
__device__ __forceinline__ unsigned xb_add(unsigned* p, unsigned v) { return __hip_atomic_fetch_add(p, v, __ATOMIC_RELAXED, __HIP_MEMORY_SCOPE_AGENT); }
__device__ __forceinline__ unsigned xb_xcc_id() { return (unsigned)__builtin_amdgcn_s_getreg((3 << 11) | 20) & 0xFu; }
#define XB_SPIN(cond, bar) do { unsigned _sp = 0; while (cond) { __builtin_amdgcn_s_sleep(1); \
    if ((++_sp & 255u) == 0u) { if (xb_ld(&(bar)[XB_TMO])) break; if (_sp > XB_SPIN_CAP) { atomicAdd(&(bar)[XB_TMO], 1u); break; } } } } while (0)
struct XcdBarrier { unsigned* bar; unsigned x; volatile LAS unsigned* st; };
__device__ __forceinline__ XcdBarrier xcd_barrier_post(unsigned* bar, volatile LAS unsigned* st) {
    XcdBarrier b; b.bar = bar; b.x = xb_xcc_id(); b.st = st;
    if (threadIdx.x == 0) (void)xb_add(&bar[XB_XCNT(b.x)], 1u);
    return b;
}
__device__ __forceinline__ void xcd_barrier_complete(unsigned* bar, unsigned x, unsigned& nloc, unsigned& nx) {
    const unsigned G = gridDim.x * gridDim.y * gridDim.z;
    unsigned sum, cnt, mine, sp = 0u;
    for (;;) {
        sum = 0u; cnt = 0u; mine = 0u;
#pragma unroll
        for (unsigned j = 0; j < 16; ++j) { const unsigned c = xb_ld(&bar[XB_XCNT(j)]); sum += c; cnt += (c > 0u) ? 1u : 0u; mine = (j == x) ? c : mine; }
        if (sum == G) break;
        __builtin_amdgcn_s_sleep(1);
        if ((++sp & 255u) == 0u) { if (xb_ld(&bar[XB_TMO])) break; if (sp > XB_SPIN_CAP) { atomicAdd(&bar[XB_TMO], 1u); break; } }
    }
    nloc = mine > 0u ? mine : 1u; nx = cnt > 0u ? cnt : 1u;
}
__device__ __forceinline__ void xcd_barrier(const XcdBarrier& b, const bool leader  ) {
    asm volatile("s_waitcnt vmcnt(0)" ::: "memory");
    __syncthreads();
    if (leader) {
        unsigned* bar = b.bar;
        __builtin_amdgcn_s_waitcnt(0);
        unsigned nloc = b.st[0], nx = b.st[1];
        if (nloc == 0u) { xcd_barrier_complete(bar, b.x, nloc, nx); b.st[0] = nloc; b.st[1] = nx; }
        const unsigned old = xb_add(&bar[XB_XSUB(b.x)], 1u);
        const unsigned gen = old / nloc;
        if (old + 1u == (gen + 1u) * nloc) {
            __builtin_amdgcn_fence(__ATOMIC_RELEASE, "agent");
            asm volatile("s_waitcnt vmcnt(0)" ::: "memory");
            const unsigned og = xb_add(&bar[XB_TOP], 1u);
            const unsigned tg = og / nx;
            if (og + 1u == (tg + 1u) * nx) xb_add(&bar[XB_TOPGEN], 1u);
            else XB_SPIN(xb_ld(&bar[XB_TOPGEN]) == tg, bar);
            __builtin_amdgcn_fence(__ATOMIC_ACQUIRE, "agent");
            xb_add(&bar[XB_XGEN(b.x)], 1u);
            asm volatile("s_waitcnt vmcnt(0)" ::: "memory");
        } else {
            XB_SPIN(xb_ld(&bar[XB_XGEN(b.x)]) == gen, bar);
            __builtin_amdgcn_fence(__ATOMIC_ACQUIRE, "agent");
            asm volatile("s_waitcnt vmcnt(0)" ::: "memory");
        }
    }
    __syncthreads();
}

struct Args {
    const float* in[28];
    float* out; unsigned char* ws;
    int ph_lo, ph_hi;
};
enum { I_X = 0, I_WIN, I_BIN, I_REL, I_SLNG, I_SLNB, I_WS, I_BS, I_LRE, I_LIM, I_LDT, I_BRE, I_BIM, I_CRE, I_CIM, I_DSK, I_WGLU, I_BGLU, I_WPA, I_WPB, I_WPC, I_WO,
       I_LN1G, I_LN1B, I_WFF1, I_WFF2, I_LN2G, I_LN2B };

typedef const __attribute__((address_space(4))) unsigned char* kptr_t;
#define KIN(kp, i)  ((const float*)(const GAS float*)(*(const float* const __attribute__((address_space(4)))*)((kp) + 8 * (i))))
#define KOUT(kp)    ((float*)(GAS float*)(*(float* const __attribute__((address_space(4)))*)((kp) + 224)))
#define KWS(kp)     ((unsigned char*)(GAS unsigned char*)(*(unsigned char* const __attribute__((address_space(4)))*)((kp) + 232)))
static_assert(sizeof(Args) == 248, "Args layout");

#define EPI_ROWS_BEGIN  _Pragma("unroll") for (int ai = 0; ai < 2; ++ai) _Pragma("unroll") for (int m = 0; m < 4; ++m) { const int rl = ai * 128 + wr * 64 + m * 16 + fr;
#define EPI_ROWS_END    asm volatile("" ::: "memory"); }
#define EPI_LOADV(v, ai, bj, m) float v[8]; { const f32x4 a0 = acc[ai][bj][m][0], a1 = acc[ai][bj][m][1]; v[0] = a0[0]; v[1] = a0[1]; v[2] = a0[2]; v[3] = a0[3]; v[4] = a1[0]; v[5] = a1[1]; v[6] = a1[2]; v[7] = a1[3]; }

struct EpiInProj {
    static constexpr bool PERM = true;
    bf16_t *Q, *Kb, *U, *UC, *G; const float* bias;
    template <int MODE> __device__ __forceinline__ void run(const f32x4 (&acc)[2][2][4][2], bf16_t* base, int ld, int row0, int colt, int bcol0, int wr, int wc, int fr, int fq) const {
        f32x4 bv[2][2];
#pragma unroll
        for (int bj = 0; bj < 2; ++bj)
#pragma unroll
            for (int n = 0; n < 2; ++n) bv[bj][n] = *(const f32x4*)(bias + bcol0 + bj * 128 + 4 * n);
        EPI_ROWS_BEGIN
            bf16_t* rowp = base + (size_t)(row0 + rl) * ld + colt + wc * 32 + 8 * fq;
#pragma unroll
            for (int bj = 0; bj < 2; ++bj) { EPI_LOADV(v, ai, bj, m)
#pragma unroll
                for (int j = 0; j < 8; ++j) { float x = v[j] + bv[bj][j >> 2][j & 3];
                    if (MODE == 0) x *= 0.125f * LOG2E; else if (MODE == 2) x = gelu_tanh(x); else if (MODE == 3) x = fast_sigmoid(x);
                    v[j] = x; }
                *(u32x4*)(rowp + bj * 128) = pack8(v); }
        EPI_ROWS_END
    }
    __device__ __forceinline__ void operator()(const f32x4 (&acc)[2][2][4][2], const Unit& u, int wr, int wc, int fr, int fq) const {
        const int pn = u.pn, row0 = u.pm * 256, bcol0 = pn * 256 + wc * 32 + 8 * fq;
        if (pn < 6) run<0>(acc, Q, 1536, row0, pn * 256, bcol0, wr, wc, fr, fq);
        else if (pn < 12) run<1>(acc, Kb, 1536, row0, (pn - 6) * 256, bcol0, wr, wc, fr, fq);
        else if (pn < 15) run<2>(acc, U, 768, row0, (pn - 12) * 256, bcol0, wr, wc, fr, fq);
        else if (pn < 18) run<1>(acc, UC, 768, row0, (pn - 15) * 256, bcol0, wr, wc, fr, fq);
        else run<3>(acc, G, 6144, row0, (pn - 18) * 256, bcol0, wr, wc, fr, fq);
    }
};
struct EpiSwap {
    static constexpr bool PERM = true;
    bf16_t *VT, *VGT; const float* bias; int nvt;
    __device__ __forceinline__ void operator()(const f32x4 (&acc)[2][2][4][2], const Unit& u, int wr, int wc, int fr, int fq) const {
        const bool isv = u.pm < nvt;
        bf16_t* base = isv ? VT + (size_t)u.pm * 256 * MTOK : VGT + (size_t)(u.pm - nvt) * 256 * MTOK;
        const int col0 = u.pn * 256 + wc * 32 + 8 * fq;
        EPI_ROWS_BEGIN
            const float bs = bias[u.pm * 256 + rl];
            bf16_t* rowp = base + (size_t)rl * MTOK + col0;
#pragma unroll
            for (int bj = 0; bj < 2; ++bj) { EPI_LOADV(v, ai, bj, m)
#pragma unroll
                for (int j = 0; j < 8; ++j) { const float x = v[j] + bs; v[j] = isv ? x : gelu_tanh(x); }
                *(u32x4*)(rowp + bj * 128) = pack8(v); }
        EPI_ROWS_END
    }
};
struct EpiS5A {
    static constexpr bool PERM = true;
    bf16_t* YI; float* E;
    __device__ __forceinline__ void operator()(const f32x4 (&acc)[2][2][4][2], const Unit& u, int wr, int wc, int fr, int fq) const {
        const int n0 = u.pm * 256, g = u.g;
        if (u.pn < 4) {
            EPI_ROWS_BEGIN
#pragma unroll
                for (int bj = 0; bj < 2; ++bj) { EPI_LOADV(v, ai, bj, m)
                    const int col = u.pn * 256 + bj * 128 + wc * 32 + 8 * fq, t = col >> 4, h0 = col & 15;
                    *(u32x4*)(YI + ((size_t)(n0 + rl) * 64 + t) * 768 + g * 16 + h0) = pack8(v); }
            EPI_ROWS_END
        } else {
            EPI_ROWS_BEGIN
                { const int col = wc * 32 + 8 * fq; float* p = E + ((size_t)(n0 + rl) * 48 + g) * 128 + col;
                  *(f32x4*)p = acc[ai][0][m][0]; *(f32x4*)(p + 4) = acc[ai][0][m][1]; }
            EPI_ROWS_END
        }
    }
};
struct EpiS5B {
    static constexpr bool PERM = true;
    const bf16_t* YI; const bf16_t* UC; const float* dsk; bf16_t* YC;
    __device__ __forceinline__ void operator()(const f32x4 (&acc)[2][2][4][2], const Unit& u, int wr, int wc, int fr, int fq) const {
        const int n0 = u.pm * 256, g = u.g;
        EPI_ROWS_BEGIN
#pragma unroll
            for (int bj = 0; bj < 2; ++bj) { EPI_LOADV(v, ai, bj, m)
                const int col = u.pn * 256 + bj * 128 + wc * 32 + 8 * fq, t = col >> 4, h0 = col & 15;
                const size_t off = ((size_t)(n0 + rl) * 64 + t) * 768 + g * 16 + h0;
                float yi[8], uu[8]; unpack8(*(const u32x4*)(YI + off), yi); unpack8(*(const u32x4*)(UC + off), uu);
                const f32x4 d0 = *(const f32x4*)(dsk + g * 16 + h0), d1 = *(const f32x4*)(dsk + g * 16 + h0 + 4);
#pragma unroll
                for (int j = 0; j < 8; ++j) v[j] = gelu_tanh(v[j] + yi[j] + (j < 4 ? d0[j & 3] : d1[j & 3]) * uu[j]);
                *(u32x4*)(YC + off) = pack8(v); }
        EPI_ROWS_END
    }
};
struct EpiGlu {
    static constexpr bool PERM = true;
    const bf16_t* YC; const float* bias; bf16_t* YC2;
    __device__ __forceinline__ void operator()(const f32x4 (&acc)[2][2][4][2], const Unit& u, int wr, int wc, int fr, int fq) const {
        const int col0 = u.pn * 256 + wc * 32 + 8 * fq;
        EPI_ROWS_BEGIN
#pragma unroll
            for (int bj = 0; bj < 2; ++bj) { EPI_LOADV(v, ai, bj, m)
                const int col = col0 + bj * 128; const size_t off = (size_t)(u.pm * 256 + rl) * 768 + col;
                float y[8]; unpack8(*(const u32x4*)(YC + off), y);
                const f32x4 b0 = *(const f32x4*)(bias + col), b1 = *(const f32x4*)(bias + col + 4);
#pragma unroll
                for (int j = 0; j < 8; ++j) v[j] = y[j] * fast_sigmoid(v[j] + (j < 4 ? b0[j & 3] : b1[j & 3]));
                *(u32x4*)(YC2 + off) = pack8(v); }
        EPI_ROWS_END
    }
};
template <bool ACCUM> struct EpiMerge {
    static constexpr bool PERM = true;
    const bf16_t* G; bf16_t* O;
    __device__ __forceinline__ void operator()(const f32x4 (&acc)[2][2][4][2], const Unit& u, int wr, int wc, int fr, int fq) const {
        const int col0 = u.pn * 256 + wc * 32 + 8 * fq;
        EPI_ROWS_BEGIN
#pragma unroll
            for (int bj = 0; bj < 2; ++bj) { EPI_LOADV(v, ai, bj, m)
                const int col = col0 + bj * 128; const size_t r = (size_t)(u.pm * 256 + rl);
                float gt[8]; unpack8(*(const u32x4*)(G + r * 6144 + col), gt);
                bf16_t* op = O + r * 2048 + col;
                if (ACCUM) { float pv[8]; unpack8(*(const u32x4*)op, pv);
#pragma unroll
                    for (int j = 0; j < 8; ++j) v[j] = pv[j] + gt[j] * v[j]; }
                else {
#pragma unroll
                    for (int j = 0; j < 8; ++j) v[j] = gt[j] * v[j]; }
                *(u32x4*)op = pack8(v); }
        EPI_ROWS_END
    }
};
struct EpiResid {
    static constexpr bool PERM = false;
    const float* xres; float* out;
    __device__ __forceinline__ void operator()(const f32x4 (&acc)[2][2][4][2], const Unit& u, int wr, int wc, int fr, int fq) const {
        const int col0 = u.pn * 256 + wc * 32 + 4 * fq;
        EPI_ROWS_BEGIN
            const size_t off = (size_t)(u.pm * 256 + rl) * DM + col0;
#pragma unroll
            for (int bj = 0; bj < 2; ++bj)
#pragma unroll
                for (int n = 0; n < 2; ++n) { const f32x4 xr = *(const f32x4*)(xres + off + bj * 128 + n * 16); *(f32x4*)(out + off + bj * 128 + n * 16) = xr * ALPHA + acc[ai][bj][m][n]; }
        EPI_ROWS_END
    }
};
struct EpiSwiglu {
    static constexpr bool PERM = true;
    bf16_t* H;
    __device__ __forceinline__ void operator()(const f32x4 (&acc)[2][2][4][2], const Unit& u, int wr, int wc, int fr, int fq) const {
        const int col0 = u.pn * 128 + wc * 32 + 8 * fq;
        EPI_ROWS_BEGIN
            { EPI_LOADV(gv, ai, 0, m) EPI_LOADV(uv, ai, 1, m)
#pragma unroll
              for (int j = 0; j < 8; ++j) gv[j] = silu(gv[j]) * uv[j];
              *(u32x4*)(H + (size_t)(u.pm * 256 + rl) * DFF + col0) = pack8(gv); }
        EPI_ROWS_END
    }
};

struct Frame {
    LAS unsigned char* lds;
    int tid, lane, wave, vcu, G;
};

__device__ __forceinline__ void transpose_item(const float* W, int K, int N, bf16_t* WT, int k0, int n0s, int n0d, LAS float* scr, int lane) {
#pragma unroll 8
    for (int i = 0; i < 32; ++i) { const int kk = 2 * i + (lane >> 5); scr[kk * 33 + (lane & 31)] = W[(size_t)(k0 + kk) * N + n0s + (lane & 31)]; }
    asm volatile("s_waitcnt lgkmcnt(0)" ::: "memory");
    const int c = lane & 7;
#pragma unroll
    for (int j = 0; j < 4; ++j) { const int n = (lane >> 3) + 8 * j; const LAS float* s = scr + (8 * c) * 33 + n;
        u32x4 o; o.x = cvt_pk_bf16(s[0 * 33], s[1 * 33]); o.y = cvt_pk_bf16(s[2 * 33], s[3 * 33]); o.z = cvt_pk_bf16(s[4 * 33], s[5 * 33]); o.w = cvt_pk_bf16(s[6 * 33], s[7 * 33]);
        *(u32x4*)(WT + (size_t)(n0d + n) * K + k0 + 8 * c) = o; }
    asm volatile("s_waitcnt lgkmcnt(0)" ::: "memory");
}
__device__ __forceinline__ int inproj_src_col(int d) {
    if (d < 3072) return d;
    if (d < 3840) return 4608 + (d - 3072);
    if (d < 4608) return 6144 + (d - 3840);
    if (d < 10752) return 6912 + (d - 4608);
    if (d < 11264) return 3072 + (d - 10752);
    if (d < 12032) return 5376 + (d - 11264);
    return 3072 + 512 + (d - 12032);
}
__device__ __forceinline__ int ff1_src_col(int d) { const int pn = d >> 8, w = d & 255; return (w < 128) ? (128 * pn + w) : (DFF + 128 * pn + (w - 128)); }

__device__ __forceinline__ void phase_convert(const Frame& F, kptr_t kp, int l) {
    unsigned char* ws = KWS(kp);
    LAS float* scr = (LAS float*)(F.lds + RING_OFF + F.wave * 16384);
    const int gw = F.vcu * NWAVES + F.wave, NGW = F.G * NWAVES;
    constexpr int I_IN = (DM / 64) * (NCOLS_IN / 32), I_GLU = (768 / 64) * (768 / 32), I_PA = (512 / 64) * (DM / 32), I_PB = (768 / 64) * (DM / 32), I_O = (DM / 64) * (DM / 32),
                  I_F1 = (DM / 64) * (2 * DFF / 32), I_F2 = (DFF / 64) * (DM / 32);
    constexpr int NITEMS = I_IN + I_GLU + I_PA + 2 * I_PB + I_O + I_F1 + I_F2;
    for (int it = gw; it < NITEMS; it += NGW) {
        int r = it;
        if (r < I_IN) { const int nb = NCOLS_IN / 32, kb = r / nb, n0d = (r % nb) * 32; transpose_item(KIN(kp, I_WIN) + (size_t)l * DM * NCOLS_IN, DM, NCOLS_IN, (bf16_t*)(ws + WS_WIN), kb * 64, inproj_src_col(n0d), n0d, scr, F.lane); continue; } r -= I_IN;
        if (r < I_GLU) { const int nb = 768 / 32, kb = r / nb, n0 = (r % nb) * 32; transpose_item(KIN(kp, I_WGLU) + (size_t)l * 768 * 768, 768, 768, (bf16_t*)(ws + WS_WGLU), kb * 64, n0, n0, scr, F.lane); continue; } r -= I_GLU;
        if (r < I_PA) { const int nb = DM / 32, kb = r / nb, n0 = (r % nb) * 32; transpose_item(KIN(kp, I_WPA) + (size_t)l * 512 * DM, 512, DM, (bf16_t*)(ws + WS_WPA), kb * 64, n0, n0, scr, F.lane); continue; } r -= I_PA;
        if (r < I_PB) { const int nb = DM / 32, kb = r / nb, n0 = (r % nb) * 32; transpose_item(KIN(kp, I_WPB) + (size_t)l * 768 * DM, 768, DM, (bf16_t*)(ws + WS_WPB), kb * 64, n0, n0, scr, F.lane); continue; } r -= I_PB;
        if (r < I_PB) { const int nb = DM / 32, kb = r / nb, n0 = (r % nb) * 32; transpose_item(KIN(kp, I_WPC) + (size_t)l * 768 * DM, 768, DM, (bf16_t*)(ws + WS_WPC), kb * 64, n0, n0, scr, F.lane); continue; } r -= I_PB;
        if (r < I_O) { const int nb = DM / 32, kb = r / nb, n0 = (r % nb) * 32; transpose_item(KIN(kp, I_WO) + (size_t)l * DM * DM, DM, DM, (bf16_t*)(ws + WS_WO), kb * 64, n0, n0, scr, F.lane); continue; } r -= I_O;
        if (r < I_F1) { const int nb = 2 * DFF / 32, kb = r / nb, n0d = (r % nb) * 32; transpose_item(KIN(kp, I_WFF1) + (size_t)l * DM * 2 * DFF, DM, 2 * DFF, (bf16_t*)(ws + WS_WFF1), kb * 64, ff1_src_col(n0d), n0d, scr, F.lane); continue; } r -= I_F1;
        { const int nb = DM / 32, kb = r / nb, n0 = (r % nb) * 32; transpose_item(KIN(kp, I_WFF2) + (size_t)l * DFF * DM, DFF, DM, (bf16_t*)(ws + WS_WFF2), kb * 64, n0, n0, scr, F.lane); }
    }
    const int gt = F.vcu * 512 + F.tid, NGT = F.G * 512;
    if (l == 0) {
        const f32x4* x4 = (const f32x4*)KIN(kp, I_X); u32x2* o = (u32x2*)(ws + WS_XB);
        for (size_t i = gt; i < (size_t)MTOK * DM / 4; i += NGT) { const f32x4 v = x4[i]; u32x2 w; w.x = cvt_pk_bf16(v[0], v[1]); w.y = cvt_pk_bf16(v[2], v[3]); o[i] = w; }
    }
    { float* br = (float*)(ws + WS_MISC + MS_BIASR); const float* b = KIN(kp, I_BIN) + (size_t)l * NCOLS_IN;
      for (int i = gt; i < NCOLS_IN; i += NGT) br[i] = b[inproj_src_col(i)]; }
    { bf16_t* wt = (bf16_t*)(ws + WS_MISC + MS_WTRIL); const float* w = KIN(kp, I_WS) + (size_t)l * 6 * 128 * 128;
      for (int i = gt; i < 6 * 128 * 128 / 2; i += NGT) { const int e = 2 * i, t = (e >> 7) & 127, s = e & 127; const float w0 = (s <= t) ? w[e] : 0.f, w1 = (s + 1 <= t) ? w[e + 1] : 0.f; ((unsigned*)wt)[i] = cvt_pk_bf16(w0, w1); } }
}
__device__ __forceinline__ void phase_tables(const Frame& F, kptr_t kp) {
    unsigned char* ws = KWS(kp);
    const int gt0 = F.vcu * 512 + F.tid;
    if (gt0 < DEPTH * 48 * 64) {
        const int l = gt0 / 3072, gt = gt0 % 3072;
        const int g = gt >> 6;
        const double dt = exp((double)KIN(kp, I_LDT)[l * 48 + g]);
        const double lr = (double)KIN(kp, I_LRE)[(size_t)l * 3072 + gt], li = (double)KIN(kp, I_LIM)[(size_t)l * 3072 + gt];
        const double mag = exp(lr * dt), ang = li * dt;
        const double abr = mag * cos(ang), abi = mag * sin(ang);
        const double nrm = lr * lr + li * li;
        const double cr = ((abr - 1.0) * lr + abi * li) / nrm, ci = (abi * lr - (abr - 1.0) * li) / nrm;
        f32x2* BB = (f32x2*)(ws + WS_TAB + (size_t)l * TAB_LAYER + TAB_BB) + (size_t)gt * 16;
        const float* bre = KIN(kp, I_BRE) + ((size_t)l * 3072 + gt) * 16; const float* bim = KIN(kp, I_BIM) + ((size_t)l * 3072 + gt) * 16;
        for (int h = 0; h < 16; ++h) { const double br_ = bre[h], bi_ = bim[h]; BB[h] = (f32x2){(float)(cr * br_ - ci * bi_), (float)(cr * bi_ + ci * br_)}; }
        f32x2* PW = (f32x2*)(ws + WS_TAB + (size_t)l * TAB_LAYER + TAB_PW) + (size_t)gt * 65;
        double pr = 1.0, pi = 0.0;
        for (int j = 0; j <= 64; ++j) { PW[j] = (f32x2){(float)pr, (float)pi}; const double nr = pr * abr - pi * abi, ni = pr * abi + pi * abr; pr = nr; pi = ni; }
    }
}
__device__ __forceinline__ void phase_kj(const Frame& F, kptr_t kp, int l) {
    unsigned char* ws = KWS(kp);
    const int gt = F.vcu * 512 + F.tid, NGT = F.G * 512;
    const f32x2* PW = (const f32x2*)(ws + WS_TAB + (size_t)l * TAB_LAYER + TAB_PW); const f32x2* BB = (const f32x2*)(ws + WS_TAB + (size_t)l * TAB_LAYER + TAB_BB);
    const float* cre = KIN(kp, I_CRE) + (size_t)l * 48 * 16 * 64; const float* cim = KIN(kp, I_CIM) + (size_t)l * 48 * 16 * 64;
    float* KJ = (float*)(ws + WS_MISC + MS_KJ);
    for (int i = gt; i < 48 * 64 * 256; i += NGT) {
        const int h = i & 15, hp = (i >> 4) & 15, j = (i >> 8) & 63, g = i >> 14;
        float s = 0.f;
        for (int p = 0; p < 64; ++p) {
            const float c_r = cre[(g * 16 + hp) * 64 + p], c_i = cim[(g * 16 + hp) * 64 + p];
            const f32x2 pw = PW[(size_t)(g * 64 + p) * 65 + j], bb = BB[(size_t)(g * 64 + p) * 16 + h];
            const float wr_ = c_r * pw.x - c_i * pw.y, wi_ = c_r * pw.y + c_i * pw.x;
            s += wr_ * bb.x - wi_ * bb.y;
        }
        KJ[i] = s;
    }
}
__device__ __forceinline__ void phase_s5mats(const Frame& F, kptr_t kp, int l) {
    unsigned char* ws = KWS(kp);
    const int gt = F.vcu * 512 + F.tid, NGT = F.G * 512;
    const f32x2* PW = (const f32x2*)(ws + WS_TAB + (size_t)l * TAB_LAYER + TAB_PW); const f32x2* BB = (const f32x2*)(ws + WS_TAB + (size_t)l * TAB_LAYER + TAB_BB);
    const float* KJ = (const float*)(ws + WS_MISC + MS_KJ);
    bf16_t* BT = (bf16_t*)(ws + WS_S5BT);
    for (int i = gt; i < 48 * 1152 * 128; i += NGT) {
        const int ch = i & 127, row = (i >> 7) % 1152, g = (i >> 7) / 1152;
        const int k0 = ch * 8, s = k0 >> 4, h0 = k0 & 15;
        float v[8];
        if (row < 1024) {
            const int t = row >> 4, hp = row & 15;
            if (s <= t) { const float* kq = KJ + (((size_t)g * 64 + (t - s)) * 16 + hp) * 16 + h0; const f32x4 k0v = *(const f32x4*)kq, k1v = *(const f32x4*)(kq + 4);
                v[0] = k0v[0]; v[1] = k0v[1]; v[2] = k0v[2]; v[3] = k0v[3]; v[4] = k1v[0]; v[5] = k1v[1]; v[6] = k1v[2]; v[7] = k1v[3]; }
            else {
#pragma unroll
                for (int j = 0; j < 8; ++j) v[j] = 0.f; }
        } else {
            const int r2 = row - 1024, ri = r2 >> 6, p = r2 & 63;
            const f32x2 pw = PW[(size_t)(g * 64 + p) * 65 + (63 - s)];
#pragma unroll
            for (int j = 0; j < 8; ++j) { const f32x2 bb = BB[(size_t)(g * 64 + p) * 16 + h0 + j]; v[j] = ri ? (pw.x * bb.y + pw.y * bb.x) : (pw.x * bb.x - pw.y * bb.y); }
        }
        *(u32x4*)(BT + ((size_t)g * 1152 + row) * 1024 + k0) = pack8(v);
    }
    const float* cre = KIN(kp, I_CRE) + (size_t)l * 48 * 16 * 64; const float* cim = KIN(kp, I_CIM) + (size_t)l * 48 * 16 * 64;
    bf16_t* QM = (bf16_t*)(ws + WS_S5QM);
    for (int i = gt; i < 48 * 1024 * 32; i += NGT) {
        const int ch = i & 31, row = (i >> 5) & 1023, g = i >> 15;
        const int t = row >> 4, hp = row & 15, k0 = ch * 8;
        float v[8];
        if (k0 < 128) {
            const int ri = k0 >> 6, p0 = k0 & 63;
#pragma unroll
            for (int j = 0; j < 8; ++j) { const int p = p0 + j; const float c_r = cre[(g * 16 + hp) * 64 + p], c_i = cim[(g * 16 + hp) * 64 + p]; const f32x2 pw = PW[(size_t)(g * 64 + p) * 65 + t + 1];
                v[j] = ri ? -(c_r * pw.y + c_i * pw.x) : (c_r * pw.x - c_i * pw.y); }
        } else {
#pragma unroll
            for (int j = 0; j < 8; ++j) v[j] = 0.f;
        }
        *(u32x4*)(QM + ((size_t)g * 1024 + row) * 256 + k0) = pack8(v);
    }
}

__device__ __forceinline__ void attn_wave(const Frame& F, unsigned char* ws, int g, int b, int h, int blk, const LAS float* tab) {
    const int lane = F.lane, q = lane & 31, hh = lane >> 5;
    const int dil = (g == 0) ? 1 : (g == 1 ? 4 : 16), Ls = SEQ / dil, nblk = Ls / 32;
    const int c = blk / nblk, m0 = (blk % nblk) * 32;
    const int gh = g * 8 + h;
    bf16_t* Qb = (bf16_t*)(ws + WS_Q); const bf16_t* Kb = (const bf16_t*)(ws + WS_K); const bf16_t* VT = (const bf16_t*)(ws + WS_VT);
    const size_t tq = (size_t)b * SEQ + (size_t)(m0 + q) * dil + c;
    bf16_t* qrow = Qb + tq * 1536 + gh * 64;
    bf16x8 qf[4];
#pragma unroll
    for (int s = 0; s < 4; ++s) qf[s] = *(const bf16x8*)(qrow + s * 16 + hh * 8);
    const int jmin = (m0 < 128) ? (128 - m0) / 32 : 0;
    f32x16 sc[5];
    const LAS float* tb = tab + gh * 192;
    float mx = -3.0e38f;
#pragma unroll
    for (int j = 0; j < 5; ++j) {
        if (j >= jmin) {
            const int mk = m0 - 128 + 32 * j + q;
            const bf16_t* krow = Kb + ((size_t)b * SEQ + (size_t)mk * dil + c) * 1536 + gh * 64;
            f32x16 acc;
#pragma unroll
            for (int i = 0; i < 16; ++i) acc[i] = 0.f;
#pragma unroll
            for (int s = 0; s < 4; ++s) { const bf16x8 kf = *(const bf16x8*)(krow + s * 16 + hh * 8); acc = __builtin_amdgcn_mfma_f32_32x32x16_bf16(kf, qf[s], acc, 0, 0, 0); }
#pragma unroll
            for (int i = 0; i < 16; ++i) { const int ki = (i & 3) + 8 * (i >> 2) + 4 * hh; const float v = acc[i] + tb[159 + q - 32 * j - ki]; acc[i] = v; mx = fmaxf(mx, v); }
            sc[j] = acc;
        }
    }
    mx = fmaxf(mx, shfl_xor_l(mx, 32, lane));
    float den = 0.f;
    f32x16 o0, o1;
#pragma unroll
    for (int i = 0; i < 16; ++i) { o0[i] = 0.f; o1[i] = 0.f; }
#pragma unroll
    for (int j = 0; j < 5; ++j) {
        if (j >= jmin) {
            float p[16];
#pragma unroll
            for (int i = 0; i < 16; ++i) { p[i] = __builtin_amdgcn_exp2f(sc[j][i] - mx); den += p[i]; }
            const size_t vcol = (size_t)b * SEQ + (size_t)c * Ls + (m0 - 128 + 32 * j);
#pragma unroll
            for (int s = 0; s < 2; ++s) {
                union { bf16x8 v; unsigned w[4]; } pf;
#pragma unroll
                for (int e = 0; e < 4; ++e) pf.w[e] = cvt_pk_bf16(p[8 * s + 2 * e], p[8 * s + 2 * e + 1]);
#pragma unroll
                for (int d = 0; d < 2; ++d) {
                    const bf16_t* vrow = VT + (size_t)(gh * 64 + d * 32 + q) * MTOK + vcol + 16 * s + 4 * hh;
                    union { bf16x8 v; u32x2 h2[2]; } vf;
                    vf.h2[0] = *(const u32x2*)vrow; vf.h2[1] = *(const u32x2*)(vrow + 8);
                    if (d == 0) o0 = __builtin_amdgcn_mfma_f32_32x32x16_bf16(vf.v, pf.v, o0, 0, 0, 0);
                    else        o1 = __builtin_amdgcn_mfma_f32_32x32x16_bf16(vf.v, pf.v, o1, 0, 0, 0);
                }
            }
        }
    }
    den += shfl_xor_l(den, 32, lane);
    const float rden = 1.0f / den;
#pragma unroll
    for (int d = 0; d < 2; ++d)
#pragma unroll
        for (int gq = 0; gq < 4; ++gq) { const f32x16& o = d ? o1 : o0; u32x2 w; w.x = cvt_pk_bf16(o[4 * gq] * rden, o[4 * gq + 1] * rden); w.y = cvt_pk_bf16(o[4 * gq + 2] * rden, o[4 * gq + 3] * rden);
            *(u32x2*)(qrow + d * 32 + 8 * gq + 4 * hh) = w; }
    if (hh == 0) ((float*)(ws + WS_LSE))[tq * 24 + gh] = (mx + __builtin_amdgcn_logf(den)) * LN2;
}
__device__ __forceinline__ void phase_attention(const Frame& F, kptr_t kp) {
    unsigned char* ws = KWS(kp);
    LAS float* tab = (LAS float*)(F.lds + RING_OFF);
    const float* rel = KIN(kp, I_REL);
    for (int i = F.tid; i < 24 * 192; i += 512) { const int gh = i / 192, idx = i % 192, steps = idx - 31, g = gh >> 3;
        tab[i] = (steps >= 0 && steps <= 128) ? rel[(int)T5B[g][steps] * 24 + gh] * LOG2E : -1.0e30f; }
    __syncthreads();
    for (int u = F.vcu; u < 3072; u += F.G) {
        const int g = u >> 10, r = u & 1023, b = r >> 7, r2 = r & 127, h = r2 >> 4, blk = (r2 & 15) * 8 + F.wave;
        attn_wave(F, ws, g, b, h, blk, tab);
    }
    __syncthreads();
}

__device__ __forceinline__ void phase_gmlp(const Frame& F, kptr_t kp, int l) {
    unsigned char* ws = KWS(kp);
    LAS float* part = (LAS float*)(F.lds + RING_OFF);
    LAS f32x2* stat = (LAS f32x2*)(F.lds + RING_OFF + 4096);
    const bf16_t* VGT = (const bf16_t*)(ws + WS_VGT); const bf16_t* U = (const bf16_t*)(ws + WS_U); bf16_t* YB = (bf16_t*)(ws + WS_YB);
    const bf16_t* WT = (const bf16_t*)(ws + WS_MISC + MS_WTRIL);
    const float* lng = KIN(kp, I_SLNG) + l * 768; const float* lnb = KIN(kp, I_SLNB) + l * 768; const float* bs = KIN(kp, I_BS) + l * 768;
    const int lane = F.lane, q = lane & 31, hh = lane >> 5;
    for (int ck = F.vcu; ck < MTOK / 128; ck += F.G) {
        const size_t tok0 = (size_t)ck * 128;
        { const int tt = F.tid & 127, pt = F.tid >> 7; float s = 0.f, s2 = 0.f;
          for (int ch = pt * 192; ch < pt * 192 + 192; ++ch) { const float v = __uint_as_float((unsigned)VGT[(size_t)ch * MTOK + tok0 + tt] << 16); s += v; s2 += v * v; }
          part[(pt * 128 + tt) * 2] = s; part[(pt * 128 + tt) * 2 + 1] = s2; }
        __syncthreads();
        if (F.tid < 128) { float s = 0.f, s2 = 0.f;
#pragma unroll
            for (int pt = 0; pt < 4; ++pt) { s += part[(pt * 128 + F.tid) * 2]; s2 += part[(pt * 128 + F.tid) * 2 + 1]; }
            const float mean = s * (1.0f / 768.0f), var = fmaxf(s2 * (1.0f / 768.0f) - mean * mean, 0.f);
            stat[F.tid] = (f32x2){mean, 1.0f / sqrtf(var + LN_EPS)}; }
        __syncthreads();
        const int ct = F.wave & 3, tta = (F.wave >> 2) ? 1 : 0, ttb = (F.wave >> 2) ? 2 : 3;
        for (int g = 0; g < 6; ++g) {
            const int cch = g * 128 + ct * 32 + q;
            const float gg = lng[cch], gb = lnb[cch];
            const bf16_t* vrow = VGT + (size_t)cch * MTOK + tok0;
            const bf16_t* wa = WT + ((size_t)g * 128 + tta * 32 + q) * 128; const bf16_t* wb = WT + ((size_t)g * 128 + ttb * 32 + q) * 128;
            f32x16 ca, cb;
#pragma unroll
            for (int i = 0; i < 16; ++i) { ca[i] = 0.f; cb[i] = 0.f; }
            for (int ks = 0; ks < 2 * ttb + 2; ++ks) {
                const int s0 = 16 * ks + 8 * hh;
                float vv[8]; unpack8(*(const u32x4*)(vrow + s0), vv);
#pragma unroll
                for (int j = 0; j < 8; ++j) { const f32x2 st = stat[s0 + j]; vv[j] = (vv[j] - st.x) * st.y * gg + gb; }
                union { bf16x8 v; u32x4 w; } af; af.w = pack8(vv);
                const bf16x8 bfb = *(const bf16x8*)(wb + s0);
                cb = __builtin_amdgcn_mfma_f32_32x32x16_bf16(af.v, bfb, cb, 0, 0, 0);
                if (ks < 2 * tta + 2) { const bf16x8 bfa = *(const bf16x8*)(wa + s0); ca = __builtin_amdgcn_mfma_f32_32x32x16_bf16(af.v, bfa, ca, 0, 0, 0); }
            }
#pragma unroll
            for (int w2 = 0; w2 < 2; ++w2) {
                const int tt = w2 ? ttb : tta; const f32x16& cc = w2 ? cb : ca;
                const int t = tt * 32 + q; const float bsv = bs[g * 128 + t];
                const size_t rowoff = (tok0 + t) * 768 + g * 128 + ct * 32 + 4 * hh;
#pragma unroll
                for (int gq = 0; gq < 4; ++gq) { const u32x2 uw = *(const u32x2*)(U + rowoff + 8 * gq);
                    u32x2 w; w.x = cvt_pk_bf16(bf_lo(uw.x) * (cc[4 * gq] + bsv), bf_hi(uw.x) * (cc[4 * gq + 1] + bsv)); w.y = cvt_pk_bf16(bf_lo(uw.y) * (cc[4 * gq + 2] + bsv), bf_hi(uw.y) * (cc[4 * gq + 3] + bsv));
                    *(u32x2*)(YB + rowoff + 8 * gq) = w; }
            }
        }
        __syncthreads();
    }
}

__device__ __forceinline__ void phase_carry_combine(const Frame& F, kptr_t kp, int l) {
    unsigned char* ws = KWS(kp);
    const int gt = F.vcu * 512 + F.tid, NGT = F.G * 512;
    const f32x2* PW = (const f32x2*)(ws + WS_TAB + (size_t)l * TAB_LAYER + TAB_PW);
    const float* E = (const float*)(ws + WS_E); bf16_t* XIN = (bf16_t*)(ws + WS_XIN);
    for (int i = gt; i < BATCH * 48 * 64; i += NGT) {
        const int p = i & 63, g = (i >> 6) % 48, b = (i >> 6) / 48;
        const f32x2 aT = PW[(size_t)(g * 64 + p) * 65 + 64];
        float xr = 0.f, xi = 0.f;
        for (int c = 0; c < 64; ++c) {
            const int n = b * 64 + c;
            bf16_t* xo = XIN + ((size_t)g * 512 + n) * 256;
            xo[p] = (bf16_t)(cvt_pk_bf16(xr, 0.f) & 0xffffu); xo[64 + p] = (bf16_t)(cvt_pk_bf16(xi, 0.f) & 0xffffu); xo[128 + p] = 0; xo[192 + p] = 0;
            const float er = E[((size_t)n * 48 + g) * 128 + p], ei = E[((size_t)n * 48 + g) * 128 + 64 + p];
            const float nr = aT.x * xr - aT.y * xi + er, ni = aT.x * xi + aT.y * xr + ei; xr = nr; xi = ni;
        }
    }
    const bf16_t* O = (const bf16_t*)(ws + WS_Q); const float* LSE = (const float*)(ws + WS_LSE); bf16_t* YA = (bf16_t*)(ws + WS_YA);
    for (size_t i = gt; i < (size_t)MTOK * 64; i += NGT) {
        const size_t tok = i >> 6; const int h = (int)(i >> 3) & 7, ch = (int)i & 7;
        const float l0 = LSE[tok * 24 + h], l1 = LSE[tok * 24 + 8 + h], l2 = LSE[tok * 24 + 16 + h];
        const float mx = fmaxf(l0, fmaxf(l1, l2));
        float w0 = __builtin_amdgcn_exp2f((l0 - mx) * LOG2E), w1 = __builtin_amdgcn_exp2f((l1 - mx) * LOG2E), w2 = __builtin_amdgcn_exp2f((l2 - mx) * LOG2E);
        const float rs = 1.0f / (w0 + w1 + w2); w0 *= rs; w1 *= rs; w2 *= rs;
        float o0[8], o1[8], o2[8];
        unpack8(*(const u32x4*)(O + tok * 1536 + h * 64 + ch * 8), o0); unpack8(*(const u32x4*)(O + tok * 1536 + 512 + h * 64 + ch * 8), o1); unpack8(*(const u32x4*)(O + tok * 1536 + 1024 + h * 64 + ch * 8), o2);
#pragma unroll
        for (int j = 0; j < 8; ++j) o0[j] = w0 * o0[j] + w1 * o1[j] + w2 * o2[j];
        *(u32x4*)(YA + tok * 512 + h * 64 + ch * 8) = pack8(o0);
    }
}

__device__ __forceinline__ void phase_ln(const Frame& F, kptr_t kp, const float* gam, const float* bet, bool write_bf16) {
    const int gw = F.vcu * NWAVES + F.wave, NGW = F.G * NWAVES;
    bf16_t* XB = (bf16_t*)(KWS(kp) + WS_XB);
    for (int r = gw; r < MTOK; r += NGW) {
        f32x4* xr = (f32x4*)(KOUT(kp) + (size_t)r * DM) + F.lane;
        f32x4 v[8]; float s = 0.f;
#pragma unroll
        for (int j = 0; j < 8; ++j) { v[j] = xr[64 * j]; s += (v[j][0] + v[j][1]) + (v[j][2] + v[j][3]); }
        const float mean = wave_sum(s, F.lane) * (1.0f / DM); float s2 = 0.f;
#pragma unroll
        for (int j = 0; j < 8; ++j) { v[j] = v[j] - mean; s2 += (v[j][0] * v[j][0] + v[j][1] * v[j][1]) + (v[j][2] * v[j][2] + v[j][3] * v[j][3]); }
        const float rstd = 1.0f / sqrtf(wave_sum(s2, F.lane) * (1.0f / DM) + LN_EPS);
        u32x2* ob = (u32x2*)(XB + (size_t)r * DM) + F.lane;
#pragma unroll
        for (int j = 0; j < 8; ++j) { const f32x4 gg = *((const f32x4*)gam + F.lane + 64 * j), bb = *((const f32x4*)bet + F.lane + 64 * j);
            const f32x4 o = v[j] * rstd * gg + bb; xr[64 * j] = o;
            if (write_bf16) { u32x2 w; w.x = cvt_pk_bf16(o[0], o[1]); w.y = cvt_pk_bf16(o[2], o[3]); ob[64 * j] = w; } }
    }
}

__global__ void __launch_bounds__(NWAVES * 64, 2) mk_fwd(Args args) {
    extern __shared__ __attribute__((aligned(16))) unsigned char lds_raw[];
    LAS unsigned char* const lds = (LAS unsigned char*)lds_raw;
    int wave_s = __builtin_amdgcn_readfirstlane((int)threadIdx.x >> 6); asm volatile("" : "+s"(wave_s));
    for (int u = threadIdx.x; u < (LDS_BYTES - LDSCTL_OFF) / 4; u += NWAVES * 64) ((LAS unsigned*)(lds + LDSCTL_OFF))[u] = 0u;
    __syncthreads();
#if MK_MULTI
#define GRID_BAR() do {} while (0)
#else
    (void)xcd_barrier_post((unsigned*)(args.ws + WS_CTL) + CW_BAR, (volatile LAS unsigned*)(lds + MISC_OFF) + 8);
#define GRID_BAR() do { PH_REFRESH(); unsigned* bp_ = (unsigned*)(ws + WS_CTL) + CW_BAR; asm volatile("" : "+s"(bp_)); XcdBarrier b_; b_.bar = bp_; b_.x = xb_xcc_id(); b_.st = (volatile LAS unsigned*)(lds + MISC_OFF) + 8; xcd_barrier(b_, F.tid == 0); } while (0)
#endif
    const int lo = args.ph_lo, hi = args.ph_hi;
#define IN(k) (lo <= (k) && (k) < hi)
#define SEAM(k) do { if (IN((k) + 1)) GRID_BAR(); } while (0)
    LAS unsigned char* const ring = lds + RING_OFF;

#define PH_BEGIN() kptr_t kp = (kptr_t)__builtin_amdgcn_kernarg_segment_ptr(); asm volatile("" : "+s"(kp)); unsigned char* ws = KWS(kp); \
        int bx = (int)blockIdx.x; asm volatile("" : "+s"(bx)); unsigned wz_ = (unsigned)wave_s << 6; asm volatile("" : "+s"(wz_)); int tid_ = (int)__builtin_amdgcn_mbcnt_hi(~0u, __builtin_amdgcn_mbcnt_lo(~0u, wz_)); int G_ = (int)gridDim.x; asm volatile("" : "+s"(G_)); \
        Frame F; F.lds = lds; F.tid = tid_; F.lane = tid_ & 63; F.wave = wave_s; F.G = G_; F.vcu = (G_ % 8 == 0) ? (bx % 8) * (G_ / 8) + bx / 8 : bx;
#define PH_REFRESH() do { unsigned wz2_ = (unsigned)wave_s << 6; asm volatile("" : "+s"(wz2_)); F.tid = (int)__builtin_amdgcn_mbcnt_hi(~0u, __builtin_amdgcn_mbcnt_lo(~0u, wz2_)); F.lane = F.tid & 63; } while (0)
    if (IN(0)) { PH_BEGIN(); phase_tables(F, kp); SEAM(0); }
    for (int l = 0; l < DEPTH; ++l) {
        const int pb = 1 + l * NPH;
        if (IN(pb + 0)) { PH_BEGIN(); phase_convert(F, kp, l); SEAM(pb + 0); }
        if (IN(pb + 1)) { PH_BEGIN(); phase_kj(F, kp, l); SEAM(pb + 1); }
        if (IN(pb + 2)) { PH_BEGIN(); phase_s5mats(F, kp, l); SEAM(pb + 2); }
        if (IN(pb + 3)) { PH_BEGIN();
            const float* biasr = (const float*)(ws + WS_MISC + MS_BIASR);
            { pg8::DenseSched S; S.init(ws + WS_XB, ws + WS_WIN, MTOK, 10752, DM, F.G, bx);
              EpiInProj E{(bf16_t*)(ws + WS_Q), (bf16_t*)(ws + WS_K), (bf16_t*)(ws + WS_U), (bf16_t*)(ws + WS_UC), (bf16_t*)(ws + WS_GATES), biasr};
              pg8::gemm_phase(F.tid, ring, DM, pg8::dense_op(DM), pg8::dense_op(DM), S, E); }
            PH_REFRESH();
            { pg8::SwapSched S; S.nM = 5; S.nwg = 5 * 128; S.G = F.G; S.c = bx; S.dil = 1; S.W = (const char*)(ws + WS_WIN) + (size_t)10752 * DM * 2; S.X = (const char*)(ws + WS_XB);
              EpiSwap E{(bf16_t*)(ws + WS_VT), (bf16_t*)(ws + WS_VGT), biasr + 10752, 2};
              pg8::OpDesc dB = pg8::dense_op(DM);
              pg8::gemm_phase(F.tid, ring, DM, pg8::dense_op(DM), dB, S, E); }
            PH_REFRESH();
            { pg8::SwapSched S; S.nM = 2; S.nwg = 2 * 128; S.G = F.G; S.c = bx; S.dil = 4; S.W = (const char*)(ws + WS_WIN) + (size_t)12032 * DM * 2; S.X = (const char*)(ws + WS_XB);
              EpiSwap E{(bf16_t*)(ws + WS_VT) + (size_t)512 * MTOK, (bf16_t*)(ws + WS_VGT), biasr + 12032, 2};
              pg8::OpDesc dB = pg8::dense_op(DM); dB.rs = 4u * DM * 2u;
              pg8::gemm_phase(F.tid, ring, DM, pg8::dense_op(DM), dB, S, E); }
            PH_REFRESH();
            { pg8::SwapSched S; S.nM = 2; S.nwg = 2 * 128; S.G = F.G; S.c = bx; S.dil = 16; S.W = (const char*)(ws + WS_WIN) + (size_t)12544 * DM * 2; S.X = (const char*)(ws + WS_XB);
              EpiSwap E{(bf16_t*)(ws + WS_VT) + (size_t)1024 * MTOK, (bf16_t*)(ws + WS_VGT), biasr + 12544, 2};
              pg8::OpDesc dB = pg8::dense_op(DM); dB.rs = 16u * DM * 2u;
              pg8::gemm_phase(F.tid, ring, DM, pg8::dense_op(DM), dB, S, E); }
            SEAM(pb + 3);
        }
        if (IN(pb + 4)) { PH_BEGIN();
            { pg8::GroupSched S; S.nM = 2; S.nN = 5; S.nwg = 480; S.G = F.G; S.c = bx;
              S.A = (const char*)(ws + WS_UC); S.gA = 32; S.tA = (size_t)256 * 49152 * 2;
              S.B = (const char*)(ws + WS_S5BT); S.gB = (size_t)1152 * 1024 * 2; S.tB = (size_t)256 * 1024 * 2;
              pg8::OpDesc dA; dA.rs = 49152u * 2u; dA.ks = 4u * 768u * 2u; dA.cshift = 4; dA.cstride = 768u * 2u;
              EpiS5A E{(bf16_t*)(ws + WS_YI), (float*)(ws + WS_E)};
              pg8::gemm_phase(F.tid, ring, 1024, dA, pg8::dense_op(1024), S, E); }
            PH_REFRESH();
            phase_gmlp(F, kp, l);
            phase_attention(F, kp);
            SEAM(pb + 4);
        }
        if (IN(pb + 5)) { PH_BEGIN(); phase_carry_combine(F, kp, l); SEAM(pb + 5); }
        if (IN(pb + 6)) { PH_BEGIN();
            pg8::GroupSched S; S.nM = 2; S.nN = 4; S.nwg = 384; S.G = F.G; S.c = bx;
            S.A = (const char*)(ws + WS_XIN); S.gA = (size_t)512 * 256 * 2; S.tA = (size_t)256 * 256 * 2;
            S.B = (const char*)(ws + WS_S5QM); S.gB = (size_t)1024 * 256 * 2; S.tB = (size_t)256 * 256 * 2;
            EpiS5B E{(const bf16_t*)(ws + WS_YI), (const bf16_t*)(ws + WS_UC), KIN(kp, I_DSK) + l * 768, (bf16_t*)(ws + WS_YC)};
            pg8::gemm_phase(F.tid, ring, 256, pg8::dense_op(256), pg8::dense_op(256), S, E);
            SEAM(pb + 6);
        }
        if (IN(pb + 7)) { PH_BEGIN();
            pg8::DenseSched S; S.init(ws + WS_YC, ws + WS_WGLU, MTOK, 768, 768, F.G, bx);
            EpiGlu E{(const bf16_t*)(ws + WS_YC), KIN(kp, I_BGLU) + l * 768, (bf16_t*)(ws + WS_YC2)};
            pg8::gemm_phase(F.tid, ring, 768, pg8::dense_op(768), pg8::dense_op(768), S, E);
            SEAM(pb + 7);
        }
        if (IN(pb + 8)) { PH_BEGIN();
            { pg8::DenseSched S; S.init(ws + WS_YA, ws + WS_WPA, MTOK, DM, 512, F.G, bx);
              EpiMerge<false> E{(const bf16_t*)(ws + WS_GATES), (bf16_t*)(ws + WS_MERGED)};
              pg8::gemm_phase(F.tid, ring, 512, pg8::dense_op(512), pg8::dense_op(512), S, E); }
            PH_REFRESH();
            { pg8::DenseSched S; S.init(ws + WS_YB, ws + WS_WPB, MTOK, DM, 768, F.G, bx);
              EpiMerge<true> E{(const bf16_t*)(ws + WS_GATES) + 2048, (bf16_t*)(ws + WS_MERGED)};
              pg8::gemm_phase(F.tid, ring, 768, pg8::dense_op(768), pg8::dense_op(768), S, E); }
            PH_REFRESH();
            { pg8::DenseSched S; S.init(ws + WS_YC2, ws + WS_WPC, MTOK, DM, 768, F.G, bx);
              EpiMerge<true> E{(const bf16_t*)(ws + WS_GATES) + 4096, (bf16_t*)(ws + WS_MERGED)};
              pg8::gemm_phase(F.tid, ring, 768, pg8::dense_op(768), pg8::dense_op(768), S, E); }
            SEAM(pb + 8);
        }
        if (IN(pb + 9)) { PH_BEGIN();
            pg8::DenseSched S; S.init(ws + WS_MERGED, ws + WS_WO, MTOK, DM, DM, F.G, bx);
            EpiResid E{(l == 0) ? KIN(kp, I_X) : (const float*)KOUT(kp), KOUT(kp)};
            pg8::gemm_phase(F.tid, ring, DM, pg8::dense_op(DM), pg8::dense_op(DM), S, E);
            SEAM(pb + 9);
        }
        if (IN(pb + 10)) { PH_BEGIN(); phase_ln(F, kp, KIN(kp, I_LN1G) + l * DM, KIN(kp, I_LN1B) + l * DM, true); SEAM(pb + 10); }
        if (IN(pb + 11)) { PH_BEGIN();
            pg8::DenseSched S; S.init(ws + WS_XB, ws + WS_WFF1, MTOK, 2 * DFF, DM, F.G, bx);
            EpiSwiglu E{(bf16_t*)(ws + WS_H)};
            pg8::gemm_phase(F.tid, ring, DM, pg8::dense_op(DM), pg8::dense_op(DM), S, E);
            SEAM(pb + 11);
        }
        if (IN(pb + 12)) { PH_BEGIN();
            pg8::DenseSched S; S.init(ws + WS_H, ws + WS_WFF2, MTOK, DM, DFF, F.G, bx);
            EpiResid E{(const float*)KOUT(kp), KOUT(kp)};
            pg8::gemm_phase(F.tid, ring, DFF, pg8::dense_op(DFF), pg8::dense_op(DFF), S, E);
            SEAM(pb + 12);
        }
        if (IN(pb + 13)) { PH_BEGIN(); phase_ln(F, kp, KIN(kp, I_LN2G) + l * DM, KIN(kp, I_LN2B) + l * DM, l + 1 < DEPTH); SEAM(pb + 13); }
    }
#undef IN
#undef SEAM
}

extern "C" void kernel_launch(void* const* d_in, const int* in_sizes, int n_in, void* d_out, int out_size, void* d_ws, size_t ws_size, hipStream_t stream) {
    static int grid = 0;
    if (grid == 0) {
        if (n_in != 28 || out_size != MTOK * DM || ws_size < WS_END) { fprintf(stderr, "kernel_launch: unexpected problem (n_in %d, out %d, ws %zu, need %zu)\n", n_in, out_size, ws_size, (size_t)WS_END); grid = -1; return; }
        int dev = 0, cus = 0, per_cu = 0;
        if (hipGetDevice(&dev) != hipSuccess || hipDeviceGetAttribute(&cus, hipDeviceAttributeMultiprocessorCount, dev) != hipSuccess) { grid = -1; return; }
        if (hipFuncSetAttribute((const void*)mk_fwd, hipFuncAttributeMaxDynamicSharedMemorySize, LDS_BYTES) != hipSuccess) { fprintf(stderr, "kernel_launch: hipFuncSetAttribute failed\n"); grid = -1; return; }
        if (hipOccupancyMaxActiveBlocksPerMultiprocessor(&per_cu, (const void*)mk_fwd, NWAVES * 64, LDS_BYTES) != hipSuccess || per_cu < 1) { fprintf(stderr, "kernel_launch: occupancy query says %d\n", per_cu); }
        (void)hipGetLastError();
        grid = cus;
    }
    if (grid < 0) return;
    (void)hipMemsetAsync((char*)d_ws + WS_CTL, 0, CTL_ZERO_BYTES, stream);
    Args a{};
    for (int i = 0; i < 28; ++i) a.in[i] = (const float*)d_in[i];
    a.out = (float*)d_out; a.ws = (unsigned char*)d_ws;
#if MK_MULTI
    for (int p = 0; p < 1 + DEPTH * NPH; ++p) { a.ph_lo = p; a.ph_hi = p + 1; hipLaunchKernelGGL(mk_fwd, dim3(grid), dim3(NWAVES * 64), LDS_BYTES, stream, a); }
#else
    a.ph_lo = 0; a.ph_hi = 1 + DEPTH * NPH;
    hipLaunchKernelGGL(mk_fwd, dim3(grid), dim3(NWAVES * 64), LDS_BYTES, stream, a);
#endif
    const hipError_t le = hipPeekAtLastError();
    if (le != hipSuccess) fprintf(stderr, "kernel_launch: launch failed: %s\n", hipGetErrorName(le));
}
```

```cpp
#include <hip/hip_runtime.h>
#include <cstdio>
#include <cstdint>

#ifndef MK_MULTI
#define MK_MULTI 0
#endif

#ifndef MK_REPEAT
#define MK_REPEAT (-1)
#endif
#define REP(tag) for (int rep_ = 0; rep_ < ((MK_REPEAT) == (tag) ? 2 : 1); ++rep_)
#define GAS __attribute__((address_space(1)))
#define LAS __attribute__((address_space(3)))
typedef unsigned short bf16_t;
typedef short bf16x8 __attribute__((ext_vector_type(8)));
typedef float f32x4 __attribute__((ext_vector_type(4)));
typedef float f32x2 __attribute__((ext_vector_type(2)));
typedef float f32x16 __attribute__((ext_vector_type(16)));
typedef unsigned u32x4 __attribute__((ext_vector_type(4)));
typedef unsigned u32x2 __attribute__((ext_vector_type(2)));

constexpr int DM = 2048, BATCH = 8, SEQ = 4096, DEPTH = 4, MTOK = BATCH * SEQ;
constexpr int NCOLS_IN = 13056, DFF = 5632;
constexpr float ALPHA = 1.681792830507429f;
constexpr float LN_EPS = 1e-5f;
constexpr float LOG2E = 1.4426950408889634f, LN2 = 0.6931471805599453f;
constexpr int NPH = 14;

__device__ const unsigned char T5B[3][129] = {
 {0,1,2,3,4,5,6,7,8,9,10,11,12,13,14,15,16,16,16,16,16,16,17,17,17,17,17,17,17,17,18,18,18,18,18,18,18,18,18,18,19,19,19,19,19,19,19,19,19,19,19,19,19,19,20,20,20,20,20,20,20,20,20,20,20,20,20,20,20,20,20,20,20,21,21,21,21,21,21,21,21,21,21,21,21,21,21,21,21,21,21,21,21,21,21,21,21,21,21,22,22,22,22,22,22,22,22,22,22,22,22,22,22,22,22,22,22,22,22,22,22,22,22,22,22,22,22,22,22},
 {0,4,8,12,16,16,17,17,18,18,19,19,19,19,20,20,20,20,20,21,21,21,21,21,21,22,22,22,22,22,22,22,22,22,23,23,23,23,23,23,23,23,23,23,23,23,24,24,24,24,24,24,24,24,24,24,24,24,24,24,24,24,25,25,25,25,25,25,25,25,25,25,25,25,25,25,25,25,25,25,25,25,25,26,26,26,26,26,26,26,26,26,26,26,26,26,26,26,26,26,26,26,26,26,26,26,26,26,26,26,26,26,26,27,27,27,27,27,27,27,27,27,27,27,27,27,27,27,27},
 {0,16,18,19,20,21,21,22,22,23,23,23,24,24,24,24,25,25,25,25,25,26,26,26,26,26,26,26,26,27,27,27,27,27,27,27,27,27,27,28,28,28,28,28,28,28,28,28,28,28,28,28,29,29,29,29,29,29,29,29,29,29,29,29,29,29,29,29,29,29,30,30,30,30,30,30,30,30,30,30,30,30,30,30,30,30,30,30,30,30,30,30,30,30,30,31,31,31,31,31,31,31,31,31,31,31,31,31,31,31,31,31,31,31,31,31,31,31,31,31,31,31,31,31,31,31,31,31,31}};

typedef __bf16 bf16x2_t __attribute__((ext_vector_type(2)));
__device__ __forceinline__ unsigned cvt_pk_bf16(float lo, float hi) { const f32x2 v = {lo, hi}; return __builtin_bit_cast(unsigned, __builtin_convertvector(v, bf16x2_t)); }
__device__ __forceinline__ float bf_lo(unsigned w) { return __uint_as_float(w << 16); }
__device__ __forceinline__ float bf_hi(unsigned w) { return __uint_as_float(w & 0xffff0000u); }
__device__ __forceinline__ float fast_sigmoid(float x) { return __builtin_amdgcn_rcpf(1.0f + __builtin_amdgcn_exp2f(-LOG2E * x)); }
__device__ __forceinline__ float gelu_tanh(float x) {
    const float u = x * (1.0f + 0.044715f * x * x);
    return x * __builtin_amdgcn_rcpf(1.0f + __builtin_amdgcn_exp2f(-2.0f * 0.7978845608028654f * LOG2E * u));
}
__device__ __forceinline__ float silu(float x) { return x * fast_sigmoid(x); }
__device__ __forceinline__ void unpack8(const u32x4 w, float (&f)[8]) {
    f[0] = bf_lo(w.x); f[1] = bf_hi(w.x); f[2] = bf_lo(w.y); f[3] = bf_hi(w.y); f[4] = bf_lo(w.z); f[5] = bf_hi(w.z); f[6] = bf_lo(w.w); f[7] = bf_hi(w.w);
}
__device__ __forceinline__ u32x4 pack8(const float (&f)[8]) {
    u32x4 w; w.x = cvt_pk_bf16(f[0], f[1]); w.y = cvt_pk_bf16(f[2], f[3]); w.z = cvt_pk_bf16(f[4], f[5]); w.w = cvt_pk_bf16(f[6], f[7]); return w;
}
__device__ __forceinline__ float shfl_xor_l(float v, int o, int lane) { return __int_as_float(__builtin_amdgcn_ds_bpermute((lane ^ o) << 2, __float_as_int(v))); }
__device__ __forceinline__ float wave_sum(float v, int lane) {
#pragma unroll
    for (int o = 1; o < 64; o <<= 1) v += shfl_xor_l(v, o, lane);
    return v;
}

namespace pg8 {
constexpr int BM = 256, BK = 64, HALF = 128, HTB = HALF * BK * 2, STAGE_BYTES = 8 * HTB, NXCD = 8, WGM = 8;
__host__ __device__ __forceinline__ int lds_byte(int r, int c) { const int st = (r >> 4) * 2 + (c >> 5), rr = r & 15, cc = c & 31, ob = rr * 64 + cc * 2; return st * 1024 + (ob ^ (((ob >> 9) & 1) << 5)); }
__host__ __device__ __forceinline__ void stage_rc(int b, int& R, int& C) { const int st = b / 1024, sb = b % 1024, swz = sb ^ (((sb >> 9) & 1) << 5); R = (st >> 1) * 16 + swz / 64; C = (st & 1) * 32 + (swz % 64) / 2; }
__host__ __device__ __forceinline__ int perm32(int rho) { const int n = rho >> 4, i = rho & 15; return 8 * (i >> 2) + 4 * n + (i & 3); }

struct Unit { int pm, pn, g; };
struct OpDesc { unsigned rs, ks; int cshift; unsigned cstride; };
__device__ __forceinline__ OpDesc dense_op(int K) { OpDesc d; d.rs = (unsigned)K * 2u; d.ks = 128u; d.cshift = 6; d.cstride = 0u; return d; }
__device__ __forceinline__ unsigned op_off(const OpDesc& d, int R, int C) { return (unsigned)R * d.rs + (unsigned)(C >> d.cshift) * d.cstride + (unsigned)(C & ((1 << d.cshift) - 1)) * 2u; }

template <class Epi, class Sched>
__device__ __forceinline__ void gemm_phase(const int tid_in, LAS unsigned char* lds, const int K, const OpDesc dA, const OpDesc dB, const Sched& S, const Epi& E) {
    int tid = tid_in; asm volatile("" : "+v"(tid));
    const int wid = __builtin_amdgcn_readfirstlane(tid >> 6), lane = tid & 63, wr = wid >> 2, wc = wid & 3, fr = lane & 15, fq = lane >> 4;
    const int nt = K / BK;
    unsigned voffA[2], voffB[2];
#pragma unroll
    for (int i = 0; i < 2; ++i) { int R, C; stage_rc(tid * 16 + i * 8192, R, C); const int Rb = Epi::PERM ? ((R & ~31) + perm32(R & 31)) : R;
        voffA[i] = op_off(dA, R, C); voffB[i] = op_off(dB, Rb, C); }
    const size_t kstepA = dA.ks, kstepB = dB.ks;
    const size_t hstepA = (size_t)HALF * dA.rs, hstepB = (size_t)HALF * dB.rs;
    const unsigned ldsw = (unsigned)wid * 1024u;
    const int aoff = lds_byte(wr * 64 + fr, fq * 8), boff = lds_byte(wc * 32 + fr, fq * 8);
#define PG8_SA(b, h) (((b) * 2 + (h)) * HTB)
#define PG8_SB(b, h) ((4 + (b) * 2 + (h)) * HTB)
#define PG8_STAGE(bufoff, gbase, voff) do { _Pragma("unroll") for (int _i = 0; _i < 2; ++_i) \
        __builtin_amdgcn_global_load_lds((const unsigned*)((const char*)(gbase) + (voff)[_i]), (LAS unsigned*)(lds + (bufoff) + ldsw + _i * 8192), 16, 0, 0); } while (0)
#define PG8_LDA(dst, b, h) do { _Pragma("unroll") for (int m = 0; m < 4; ++m) _Pragma("unroll") for (int k = 0; k < 2; ++k) dst[m][k] = *(const LAS bf16x8*)(lds + PG8_SA(b, h) + aoff + m * 2048 + k * 1024); } while (0)
#define PG8_LDB(dst, b, h) do { _Pragma("unroll") for (int n = 0; n < 2; ++n) _Pragma("unroll") for (int k = 0; k < 2; ++k) dst[n][k] = *(const LAS bf16x8*)(lds + PG8_SB(b, h) + boff + n * 2048 + k * 1024); } while (0)
#define PG8_MMA(ai, bj, At, Bt) do { __builtin_amdgcn_s_setprio(1); _Pragma("unroll") for (int m = 0; m < 4; ++m) _Pragma("unroll") for (int n = 0; n < 2; ++n) _Pragma("unroll") for (int k = 0; k < 2; ++k) \
        acc[ai][bj][m][n] = __builtin_amdgcn_mfma_f32_16x16x32_bf16(Bt[n][k], At[m][k], acc[ai][bj][m][n], 0, 0, 0); __builtin_amdgcn_s_setprio(0); } while (0)
#define PG8_WAIT_V(n) asm volatile("s_waitcnt vmcnt(" #n ")" ::: "memory")
#define PG8_WAIT_L(n) asm volatile("s_waitcnt lgkmcnt(" #n ")" ::: "memory")
#define PG8_BAR __builtin_amdgcn_s_barrier()
#define PG8_SCHED __builtin_amdgcn_sched_barrier(0)
    Unit cur, nxt; int ui = 0;
    if (!S.next(0, cur)) return;
    f32x4 acc[2][2][4][2];
#pragma unroll
    for (int a = 0; a < 2; ++a)
#pragma unroll
        for (int b = 0; b < 2; ++b)
#pragma unroll
            for (int m = 0; m < 4; ++m)
#pragma unroll
                for (int n = 0; n < 2; ++n) acc[a][b][m][n] = (f32x4){0.f, 0.f, 0.f, 0.f};
    bf16x8 At[4][2], B0[2][2], B1[2][2];
    const char* cA = S.pA(cur); const char* cB = S.pB(cur);
    PG8_STAGE(PG8_SB(0, 0), cB, voffB); PG8_STAGE(PG8_SB(0, 1), cB + hstepB, voffB); PG8_STAGE(PG8_SA(0, 0), cA, voffA); PG8_STAGE(PG8_SA(0, 1), cA + hstepA, voffA);
    if (wr == 1) PG8_BAR;
    PG8_WAIT_V(2); PG8_BAR;
    PG8_STAGE(PG8_SB(1, 0), cB + kstepB, voffB); PG8_STAGE(PG8_SA(1, 0), cA + kstepA, voffA); PG8_STAGE(PG8_SB(1, 1), cB + hstepB + kstepB, voffB);
    PG8_WAIT_V(6); PG8_BAR;
    for (;;) {
        const bool has_next = S.next(ui + 1, nxt);
        const char* nA = has_next ? S.pA(nxt) : cA; const char* nB = has_next ? S.pB(nxt) : cB;
        for (int t = 0; t < nt; t += 2) {
            const bool last = (t == nt - 2);
            const char* a1 = cA + (size_t)(t + 1) * kstepA;
            const char* a2 = last ? nA : cA + (size_t)(t + 2) * kstepA; const char* b2 = last ? nB : cB + (size_t)(t + 2) * kstepB;
            const char* a3 = a2 + kstepA; const char* b3 = b2 + kstepB;
            PG8_LDB(B0, 0, 0); PG8_LDB(B1, 0, 1); PG8_SCHED; PG8_LDA(At, 0, 0); PG8_STAGE(PG8_SA(1, 1), a1 + hstepA, voffA);
            PG8_WAIT_V(8); PG8_WAIT_L(0); PG8_BAR; PG8_MMA(0, 0, At, B0); PG8_MMA(0, 1, At, B1); PG8_BAR; PG8_SCHED;
            PG8_LDA(At, 0, 1); PG8_STAGE(PG8_SB(0, 0), b2, voffB); PG8_STAGE(PG8_SB(0, 1), b2 + hstepB, voffB); PG8_STAGE(PG8_SA(0, 0), a2, voffA);
            PG8_WAIT_V(8); PG8_WAIT_L(0); PG8_BAR; PG8_MMA(1, 0, At, B0); PG8_MMA(1, 1, At, B1); PG8_BAR; PG8_SCHED;
            PG8_LDB(B0, 1, 0); PG8_LDB(B1, 1, 1); PG8_SCHED; PG8_LDA(At, 1, 0); PG8_STAGE(PG8_SA(0, 1), a2 + hstepA, voffA);
            PG8_WAIT_V(8); PG8_WAIT_L(0); PG8_BAR; PG8_MMA(0, 0, At, B0); PG8_MMA(0, 1, At, B1); PG8_BAR; PG8_SCHED;
            PG8_LDA(At, 1, 1); PG8_STAGE(PG8_SB(1, 0), b3, voffB); PG8_STAGE(PG8_SB(1, 1), b3 + hstepB, voffB); PG8_STAGE(PG8_SA(1, 0), a3, voffA);
            PG8_WAIT_V(8); PG8_WAIT_L(0); PG8_BAR; PG8_MMA(1, 0, At, B0); PG8_MMA(1, 1, At, B1); PG8_BAR; PG8_SCHED;
        }
        if (wr == 0) PG8_BAR;
        E(acc, cur, wr, wc, fr, fq);
        if (!has_next) break;
#pragma unroll
        for (int a = 0; a < 2; ++a)
#pragma unroll
            for (int b = 0; b < 2; ++b)
#pragma unroll
                for (int m = 0; m < 4; ++m)
#pragma unroll
                    for (int n = 0; n < 2; ++n) acc[a][b][m][n] = (f32x4){0.f, 0.f, 0.f, 0.f};
        cur = nxt; cA = nA; cB = nB; ++ui;
        if (wr == 1) PG8_BAR;
    }
    PG8_WAIT_V(0);
    PG8_BAR;
#undef PG8_SA
#undef PG8_SB
#undef PG8_STAGE
#undef PG8_LDA
#undef PG8_LDB
#undef PG8_MMA
#undef PG8_WAIT_V
#undef PG8_WAIT_L
#undef PG8_BAR
#undef PG8_SCHED
}

struct DenseSched {
    int nM, nN, nwg, G, c; const char* A; const char* B; size_t tA, tB;
    __device__ void init(const void* A_, const void* B_, int M, int N, int K, int G_, int c_) { nM = M / BM; nN = N / BM; nwg = nM * nN; G = G_; c = c_; A = (const char*)A_; B = (const char*)B_; tA = (size_t)BM * K * 2; tB = tA; }
    __device__ bool next(int i, Unit& u) const {
        const long L = (long)i * G + c; if (L >= nwg) return false;
        int wgid = (int)L; { const int q = nwg / NXCD, r = nwg % NXCD, xcd = wgid % NXCD, off = wgid / NXCD; wgid = (xcd < r ? xcd * (q + 1) : r * (q + 1) + (xcd - r) * q) + off; }
        const int nig = WGM * nN, gid = wgid / nig, fm = gid * WGM, gsz = (nM - fm) < WGM ? (nM - fm) : WGM;
        u.pm = fm + ((wgid % nig) % gsz); u.pn = (wgid % nig) / gsz; u.g = 0; return true;
    }
    __device__ __forceinline__ const char* pA(const Unit& u) const { return A + (size_t)u.pm * tA; }
    __device__ __forceinline__ const char* pB(const Unit& u) const { return B + (size_t)u.pn * tB; }
};
struct SwapSched {
    int nM, nwg, G, c, dil; const char* W; const char* X;
    __device__ bool next(int i, Unit& u) const { const int L = i * G + c; if (L >= nwg) return false; u.pm = L % nM; u.pn = L / nM; u.g = 0; return true; }
    __device__ __forceinline__ const char* pA(const Unit& u) const { return W + (size_t)u.pm * (256 * DM * 2); }
    __device__ __forceinline__ const char* pB(const Unit& u) const {
        const int b = u.pn >> 4, o = (u.pn & 15) * 256, Ls = SEQ / dil, cc = o / Ls, m0 = o % Ls;
        return X + (size_t)(b * SEQ + m0 * dil + cc) * (DM * 2);
    }
};
struct GroupSched {
    int nM, nN, nwg, G, c; const char* A; const char* B; size_t gA, tA, gB, tB;
    __device__ bool next(int i, Unit& u) const { const int L = i * G + c; if (L >= nwg) return false; const int per = nM * nN; u.g = L / per; const int r = L % per; u.pm = r % nM; u.pn = r / nM; return true; }
    __device__ __forceinline__ const char* pA(const Unit& u) const { return A + (size_t)u.g * gA + (size_t)u.pm * tA; }
    __device__ __forceinline__ const char* pB(const Unit& u) const { return B + (size_t)u.g * gB + (size_t)u.pn * tB; }
};
}
using pg8::Unit;

constexpr size_t MiB = 1u << 20;
constexpr size_t WS_CTL = 0, CTL_ZERO_BYTES = 1 * MiB;
constexpr size_t WS_WIN  = 1 * MiB;
constexpr size_t WS_WGLU = WS_WIN + (size_t)NCOLS_IN * DM * 2;
constexpr size_t WS_WPA  = WS_WGLU + 768 * 768 * 2;
constexpr size_t WS_WPB  = WS_WPA + 2048 * 512 * 2;
constexpr size_t WS_WPC  = WS_WPB + 2048 * 768 * 2;
constexpr size_t WS_WO   = WS_WPC + 2048 * 768 * 2;
constexpr size_t WS_WFF1 = WS_WO + (size_t)DM * DM * 2;
constexpr size_t WS_WFF2 = WS_WFF1 + (size_t)2 * DFF * DM * 2;
constexpr size_t WS_MISC = WS_WFF2 + (size_t)DM * DFF * 2;
constexpr size_t MS_BIASR = 0;
constexpr size_t MS_WTRIL = 64 * 1024;
constexpr size_t MS_KJ    = MS_WTRIL + 6 * 128 * 128 * 2;
constexpr size_t MS_END   = MS_KJ + 48 * 64 * 256 * 4;
constexpr size_t WS_S5BT = ((WS_MISC + MS_END + MiB - 1) / MiB) * MiB;
constexpr size_t WS_S5QM = WS_S5BT + (size_t)(48 * 1152 + 128) * 1024 * 2;
constexpr size_t WS_XB   = ((WS_S5QM + (size_t)48 * 1024 * 256 * 2 + MiB - 1) / MiB) * MiB;
constexpr size_t WS_Q    = WS_XB + (size_t)MTOK * DM * 2;
constexpr size_t WS_K    = WS_Q + (size_t)MTOK * 1536 * 2;
constexpr size_t WS_MERGED = WS_Q;
constexpr size_t WS_VT   = WS_K + (size_t)MTOK * 1536 * 2;
constexpr size_t WS_VGT  = WS_VT + (size_t)1536 * MTOK * 2;
constexpr size_t WS_U    = WS_VGT + (size_t)768 * MTOK * 2;
constexpr size_t WS_UC   = WS_U + (size_t)MTOK * 768 * 2;
constexpr size_t WS_GATES = WS_UC + (size_t)MTOK * 768 * 2;
constexpr size_t WS_H    = WS_GATES;
constexpr size_t WS_LSE  = WS_GATES + (size_t)MTOK * 6144 * 2;
constexpr size_t WS_YA   = WS_LSE + (size_t)MTOK * 24 * 4;
constexpr size_t WS_YB   = WS_YA + (size_t)MTOK * 512 * 2;
constexpr size_t WS_YC   = WS_YB + (size_t)MTOK * 768 * 2;
constexpr size_t WS_YC2  = WS_YC + (size_t)MTOK * 768 * 2;
constexpr size_t WS_YI   = WS_YC2 + (size_t)MTOK * 768 * 2;
constexpr size_t WS_E    = WS_YI + (size_t)MTOK * 768 * 2;
constexpr size_t WS_XIN  = WS_E + (size_t)512 * 48 * 128 * 4;
constexpr size_t WS_TAB  = WS_XIN + (size_t)48 * 512 * 256 * 2;
constexpr size_t TAB_PW = 0, TAB_BB = 48 * 64 * 65 * 8, TAB_LAYER = TAB_BB + 48 * 64 * 16 * 8;
constexpr size_t WS_END  = WS_TAB + DEPTH * TAB_LAYER;
static_assert(WS_H + (size_t)MTOK * DFF * 2 <= WS_LSE, "h overlay fits in the gates");
static_assert(WS_MERGED + (size_t)MTOK * DM * 2 <= WS_VT, "merged overlay fits in q|k");

constexpr int CW_TMO = 0, CW_BAR = 4096;
constexpr int RING_OFF = 0, RING_BYTES = 131072, LDSCTL_OFF = RING_BYTES, MISC_OFF = LDSCTL_OFF + 320, LDS_BYTES = 147456;
constexpr int NWAVES = 8;

#define XB_TMO      128
#define XB_XCNT(j)  (256  + 64 * (j))
#define XB_XSUB(j)  (1280 + 64 * (j))
#define XB_XGEN(j)  (2304 + 64 * (j))
#define XB_TOP      3328
#define XB_TOPGEN   3392
#define XCD_BAR_WORDS 3456
#define XB_SPIN_CAP (1u << 18)
__device__ __forceinline__ unsigned xb_ld(unsigned* p)              { return __hip_atomic_load(p, __ATOMIC_RELAXED, __HIP_MEMORY_SCOPE_AGENT); }
__device__ __forceinline__ unsigned xb_add(unsigned* p, unsigned v) { return __hip_atomic_fetch_add(p, v, __ATOMIC_RELAXED, __HIP_MEMORY_SCOPE_AGENT); }
__device__ __forceinline__ unsigned xb_xcc_id() { return (unsigned)__builtin_amdgcn_s_getreg((3 << 11) | 20) & 0xFu; }
#define XB_SPIN(cond, bar) do { unsigned _sp = 0; while (cond) { __builtin_amdgcn_s_sleep(1); \
    if ((++_sp & 255u) == 0u) { if (xb_ld(&(bar)[XB_TMO])) break; if (_sp > XB_SPIN_CAP) { atomicAdd(&(bar)[XB_TMO], 1u); break; } } } } while (0)
struct XcdBarrier { unsigned* bar; unsigned x; volatile LAS unsigned* st; };
__device__ __forceinline__ XcdBarrier xcd_barrier_post(unsigned* bar, volatile LAS unsigned* st) {
    XcdBarrier b; b.bar = bar; b.x = xb_xcc_id(); b.st = st;
    if (threadIdx.x == 0) (void)xb_add(&bar[XB_XCNT(b.x)], 1u);
    return b;
}
__device__ __forceinline__ void xcd_barrier_complete(unsigned* bar, unsigned x, unsigned& nloc, unsigned& nx) {
    const unsigned G = gridDim.x * gridDim.y * gridDim.z;
    unsigned sum, cnt, mine, sp = 0u;
    for (;;) {
        sum = 0u; cnt = 0u; mine = 0u;
#pragma unroll
        for (unsigned j = 0; j < 16; ++j) { const unsigned c = xb_ld(&bar[XB_XCNT(j)]); sum += c; cnt += (c > 0u) ? 1u : 0u; mine = (j == x) ? c : mine; }
        if (sum == G) break;
        __builtin_amdgcn_s_sleep(1);
        if ((++sp & 255u) == 0u) { if (xb_ld(&bar[XB_TMO])) break; if (sp > XB_SPIN_CAP) { atomicAdd(&bar[XB_TMO], 1u); break; } }
    }
    nloc = mine > 0u ? mine : 1u; nx = cnt > 0u ? cnt : 1u;
}
__device__ __forceinline__ void xcd_barrier(const XcdBarrier& b, const bool leader  ) {
    asm volatile("s_waitcnt vmcnt(0)" ::: "memory");
    __syncthreads();
    if (leader) {
        unsigned* bar = b.bar;
        __builtin_amdgcn_s_waitcnt(0);
        unsigned nloc = b.st[0], nx = b.st[1];
        if (nloc == 0u) { xcd_barrier_complete(bar, b.x, nloc, nx); b.st[0] = nloc; b.st[1] = nx; }
        const unsigned old = xb_add(&bar[XB_XSUB(b.x)], 1u);
        const unsigned gen = old / nloc;
        if (old + 1u == (gen + 1u) * nloc) {
            __builtin_amdgcn_fence(__ATOMIC_RELEASE, "agent");
            asm volatile("s_waitcnt vmcnt(0)" ::: "memory");
            const unsigned og = xb_add(&bar[XB_TOP], 1u);
            const unsigned tg = og / nx;
            if (og + 1u == (tg + 1u) * nx) xb_add(&bar[XB_TOPGEN], 1u);
            else XB_SPIN(xb_ld(&bar[XB_TOPGEN]) == tg, bar);
            __builtin_amdgcn_fence(__ATOMIC_ACQUIRE, "agent");
            xb_add(&bar[XB_XGEN(b.x)], 1u);
            asm volatile("s_waitcnt vmcnt(0)" ::: "memory");
        } else {
            XB_SPIN(xb_ld(&bar[XB_XGEN(b.x)]) == gen, bar);
            __builtin_amdgcn_fence(__ATOMIC_ACQUIRE, "agent");
            asm volatile("s_waitcnt vmcnt(0)" ::: "memory");
        }
    }
    __syncthreads();
}

struct Args {
    const float* in[28];
    float* out; unsigned char* ws;
    int ph_lo, ph_hi;
};
enum { I_X = 0, I_WIN, I_BIN, I_REL, I_SLNG, I_SLNB, I_WS, I_BS, I_LRE, I_LIM, I_LDT, I_BRE, I_BIM, I_CRE, I_CIM, I_DSK, I_WGLU, I_BGLU, I_WPA, I_WPB, I_WPC, I_WO,
       I_LN1G, I_LN1B, I_WFF1, I_WFF2, I_LN2G, I_LN2B };

typedef const __attribute__((address_space(4))) unsigned char* kptr_t;
#define KIN(kp, i)  ((const float*)(const GAS float*)(*(const float* const __attribute__((address_space(4)))*)((kp) + 8 * (i))))
#define KOUT(kp)    ((float*)(GAS float*)(*(float* const __attribute__((address_space(4)))*)((kp) + 224)))
#define KWS(kp)     ((unsigned char*)(GAS unsigned char*)(*(unsigned char* const __attribute__((address_space(4)))*)((kp) + 232)))
static_assert(sizeof(Args) == 248, "Args layout");

#define EPI_ROWS_BEGIN  _Pragma("unroll") for (int ai = 0; ai < 2; ++ai) _Pragma("unroll") for (int m = 0; m < 4; ++m) { const int rl = ai * 128 + wr * 64 + m * 16 + fr;
#define EPI_ROWS_END    asm volatile("" ::: "memory"); }
#define EPI_LOADV(v, ai, bj, m) float v[8]; { const f32x4 a0 = acc[ai][bj][m][0], a1 = acc[ai][bj][m][1]; v[0] = a0[0]; v[1] = a0[1]; v[2] = a0[2]; v[3] = a0[3]; v[4] = a1[0]; v[5] = a1[1]; v[6] = a1[2]; v[7] = a1[3]; }

struct EpiInProj {
    static constexpr bool PERM = true;
    bf16_t *Q, *Kb, *U, *UC, *G; const float* bias;
    template <int MODE> __device__ __forceinline__ void run(const f32x4 (&acc)[2][2][4][2], bf16_t* base, int ld, int row0, int colt, int bcol0, int wr, int wc, int fr, int fq) const {
        f32x4 bv[2][2];
#pragma unroll
        for (int bj = 0; bj < 2; ++bj)
#pragma unroll
            for (int n = 0; n < 2; ++n) bv[bj][n] = *(const f32x4*)(bias + bcol0 + bj * 128 + 4 * n);
        EPI_ROWS_BEGIN
            bf16_t* rowp = base + (size_t)(row0 + rl) * ld + colt + wc * 32 + 8 * fq;
#pragma unroll
            for (int bj = 0; bj < 2; ++bj) { EPI_LOADV(v, ai, bj, m)
#pragma unroll
                for (int j = 0; j < 8; ++j) { float x = v[j] + bv[bj][j >> 2][j & 3];
                    if (MODE == 0) x *= 0.125f * LOG2E; else if (MODE == 2) x = gelu_tanh(x); else if (MODE == 3) x = fast_sigmoid(x);
                    v[j] = x; }
                *(u32x4*)(rowp + bj * 128) = pack8(v); }
        EPI_ROWS_END
    }
    __device__ __forceinline__ void operator()(const f32x4 (&acc)[2][2][4][2], const Unit& u, int wr, int wc, int fr, int fq) const {
        const int pn = u.pn, row0 = u.pm * 256, bcol0 = pn * 256 + wc * 32 + 8 * fq;
        if (pn < 6) run<0>(acc, Q, 1536, row0, pn * 256, bcol0, wr, wc, fr, fq);
        else if (pn < 12) run<1>(acc, Kb, 1536, row0, (pn - 6) * 256, bcol0, wr, wc, fr, fq);
        else if (pn < 15) run<2>(acc, U, 768, row0, (pn - 12) * 256, bcol0, wr, wc, fr, fq);
        else if (pn < 18) run<1>(acc, UC, 768, row0, (pn - 15) * 256, bcol0, wr, wc, fr, fq);
        else run<3>(acc, G, 6144, row0, (pn - 18) * 256, bcol0, wr, wc, fr, fq);
    }
};
struct EpiSwap {
    static constexpr bool PERM = true;
    bf16_t *VT, *VGT; const float* bias; int nvt;
    __device__ __forceinline__ void operator()(const f32x4 (&acc)[2][2][4][2], const Unit& u, int wr, int wc, int fr, int fq) const {
        const bool isv = u.pm < nvt;
        bf16_t* base = isv ? VT + (size_t)u.pm * 256 * MTOK : VGT + (size_t)(u.pm - nvt) * 256 * MTOK;
        const int col0 = u.pn * 256 + wc * 32 + 8 * fq;
        EPI_ROWS_BEGIN
            const float bs = bias[u.pm * 256 + rl];
            bf16_t* rowp = base + (size_t)rl * MTOK + col0;
#pragma unroll
            for (int bj = 0; bj < 2; ++bj) { EPI_LOADV(v, ai, bj, m)
#pragma unroll
                for (int j = 0; j < 8; ++j) { const float x = v[j] + bs; v[j] = isv ? x : gelu_tanh(x); }
                *(u32x4*)(rowp + bj * 128) = pack8(v); }
        EPI_ROWS_END
    }
};
struct EpiS5A {
    static constexpr bool PERM = true;
    bf16_t* YI; float* E;
    __device__ __forceinline__ void operator()(const f32x4 (&acc)[2][2][4][2], const Unit& u, int wr, int wc, int fr, int fq) const {
        const int n0 = u.pm * 256, g = u.g;
        if (u.pn < 4) {
            EPI_ROWS_BEGIN
#pragma unroll
                for (int bj = 0; bj < 2; ++bj) { EPI_LOADV(v, ai, bj, m)
                    const int col = u.pn * 256 + bj * 128 + wc * 32 + 8 * fq, t = col >> 4, h0 = col & 15;
                    *(u32x4*)(YI + ((size_t)(n0 + rl) * 64 + t) * 768 + g * 16 + h0) = pack8(v); }
            EPI_ROWS_END
        } else {
            EPI_ROWS_BEGIN
                { const int col = wc * 32 + 8 * fq; float* p = E + ((size_t)(n0 + rl) * 48 + g) * 128 + col;
                  *(f32x4*)p = acc[ai][0][m][0]; *(f32x4*)(p + 4) = acc[ai][0][m][1]; }
            EPI_ROWS_END
        }
    }
};
struct EpiS5B {
    static constexpr bool PERM = true;
    const bf16_t* YI; const bf16_t* UC; const float* dsk; bf16_t* YC;
    __device__ __forceinline__ void operator()(const f32x4 (&acc)[2][2][4][2], const Unit& u, int wr, int wc, int fr, int fq) const {
        const int n0 = u.pm * 256, g = u.g;
        EPI_ROWS_BEGIN
#pragma unroll
            for (int bj = 0; bj < 2; ++bj) { EPI_LOADV(v, ai, bj, m)
                const int col = u.pn * 256 + bj * 128 + wc * 32 + 8 * fq, t = col >> 4, h0 = col & 15;
                const size_t off = ((size_t)(n0 + rl) * 64 + t) * 768 + g * 16 + h0;
                float yi[8], uu[8]; unpack8(*(const u32x4*)(YI + off), yi); unpack8(*(const u32x4*)(UC + off), uu);
                const f32x4 d0 = *(const f32x4*)(dsk + g * 16 + h0), d1 = *(const f32x4*)(dsk + g * 16 + h0 + 4);
#pragma unroll
                for (int j = 0; j < 8; ++j) v[j] = gelu_tanh(v[j] + yi[j] + (j < 4 ? d0[j & 3] : d1[j & 3]) * uu[j]);
                *(u32x4*)(YC + off) = pack8(v); }
        EPI_ROWS_END
    }
};
struct EpiGlu {
    static constexpr bool PERM = true;
    const bf16_t* YC; const float* bias; bf16_t* YC2;
    __device__ __forceinline__ void operator()(const f32x4 (&acc)[2][2][4][2], const Unit& u, int wr, int wc, int fr, int fq) const {
        const int col0 = u.pn * 256 + wc * 32 + 8 * fq;
        EPI_ROWS_BEGIN
#pragma unroll
            for (int bj = 0; bj < 2; ++bj) { EPI_LOADV(v, ai, bj, m)
                const int col = col0 + bj * 128; const size_t off = (size_t)(u.pm * 256 + rl) * 768 + col;
                float y[8]; unpack8(*(const u32x4*)(YC + off), y);
                const f32x4 b0 = *(const f32x4*)(bias + col), b1 = *(const f32x4*)(bias + col + 4);
#pragma unroll
                for (int j = 0; j < 8; ++j) v[j] = y[j] * fast_sigmoid(v[j] + (j < 4 ? b0[j & 3] : b1[j & 3]));
                *(u32x4*)(YC2 + off) = pack8(v); }
        EPI_ROWS_END
    }
};
template <bool ACCUM> struct EpiMerge {
    static constexpr bool PERM = true;
    const bf16_t* G; bf16_t* O;
    __device__ __forceinline__ void operator()(const f32x4 (&acc)[2][2][4][2], const Unit& u, int wr, int wc, int fr, int fq) const {
        const int col0 = u.pn * 256 + wc * 32 + 8 * fq;
        EPI_ROWS_BEGIN
#pragma unroll
            for (int bj = 0; bj < 2; ++bj) { EPI_LOADV(v, ai, bj, m)
                const int col = col0 + bj * 128; const size_t r = (size_t)(u.pm * 256 + rl);
                float gt[8]; unpack8(*(const u32x4*)(G + r * 6144 + col), gt);
                bf16_t* op = O + r * 2048 + col;
                if (ACCUM) { float pv[8]; unpack8(*(const u32x4*)op, pv);
#pragma unroll
                    for (int j = 0; j < 8; ++j) v[j] = pv[j] + gt[j] * v[j]; }
                else {
#pragma unroll
                    for (int j = 0; j < 8; ++j) v[j] = gt[j] * v[j]; }
                *(u32x4*)op = pack8(v); }
        EPI_ROWS_END
    }
};
struct EpiResid {
    static constexpr bool PERM = false;
    const float* xres; float* out;
    __device__ __forceinline__ void operator()(const f32x4 (&acc)[2][2][4][2], const Unit& u, int wr, int wc, int fr, int fq) const {
        const int col0 = u.pn * 256 + wc * 32 + 4 * fq;
        EPI_ROWS_BEGIN
            const size_t off = (size_t)(u.pm * 256 + rl) * DM + col0;
#pragma unroll
            for (int bj = 0; bj < 2; ++bj)
#pragma unroll
                for (int n = 0; n < 2; ++n) { const f32x4 xr = *(const f32x4*)(xres + off + bj * 128 + n * 16); *(f32x4*)(out + off + bj * 128 + n * 16) = xr * ALPHA + acc[ai][bj][m][n]; }
        EPI_ROWS_END
    }
};
struct EpiSwiglu {
    static constexpr bool PERM = true;
    bf16_t* H;
    __device__ __forceinline__ void operator()(const f32x4 (&acc)[2][2][4][2], const Unit& u, int wr, int wc, int fr, int fq) const {
        const int col0 = u.pn * 128 + wc * 32 + 8 * fq;
        EPI_ROWS_BEGIN
            { EPI_LOADV(gv, ai, 0, m) EPI_LOADV(uv, ai, 1, m)
#pragma unroll
              for (int j = 0; j < 8; ++j) gv[j] = silu(gv[j]) * uv[j];
              *(u32x4*)(H + (size_t)(u.pm * 256 + rl) * DFF + col0) = pack8(gv); }
        EPI_ROWS_END
    }
};

struct Frame {
    LAS unsigned char* lds;
    int tid, lane, wave, vcu, G;
};

__device__ __forceinline__ void transpose_item(const float* W, int K, int N, bf16_t* WT, int k0, int n0s, int n0d, LAS float* scr, int lane) {
#pragma unroll 8
    for (int i = 0; i < 32; ++i) { const int kk = 2 * i + (lane >> 5); scr[kk * 33 + (lane & 31)] = W[(size_t)(k0 + kk) * N + n0s + (lane & 31)]; }
    asm volatile("s_waitcnt lgkmcnt(0)" ::: "memory");
    const int c = lane & 7;
#pragma unroll
    for (int j = 0; j < 4; ++j) { const int n = (lane >> 3) + 8 * j; const LAS float* s = scr + (8 * c) * 33 + n;
        u32x4 o; o.x = cvt_pk_bf16(s[0 * 33], s[1 * 33]); o.y = cvt_pk_bf16(s[2 * 33], s[3 * 33]); o.z = cvt_pk_bf16(s[4 * 33], s[5 * 33]); o.w = cvt_pk_bf16(s[6 * 33], s[7 * 33]);
        *(u32x4*)(WT + (size_t)(n0d + n) * K + k0 + 8 * c) = o; }
    asm volatile("s_waitcnt lgkmcnt(0)" ::: "memory");
}
__device__ __forceinline__ int inproj_src_col(int d) {
    if (d < 3072) return d;
    if (d < 3840) return 4608 + (d - 3072);
    if (d < 4608) return 6144 + (d - 3840);
    if (d < 10752) return 6912 + (d - 4608);
    if (d < 11264) return 3072 + (d - 10752);
    if (d < 12032) return 5376 + (d - 11264);
    return 3072 + 512 + (d - 12032);
}
__device__ __forceinline__ int ff1_src_col(int d) { const int pn = d >> 8, w = d & 255; return (w < 128) ? (128 * pn + w) : (DFF + 128 * pn + (w - 128)); }

__device__ __forceinline__ void phase_convert(const Frame& F, kptr_t kp, int l) {
    unsigned char* ws = KWS(kp);
    LAS float* scr = (LAS float*)(F.lds + RING_OFF + F.wave * 16384);
    const int gw = F.vcu * NWAVES + F.wave, NGW = F.G * NWAVES;
    constexpr int I_IN = (DM / 64) * (NCOLS_IN / 32), I_GLU = (768 / 64) * (768 / 32), I_PA = (512 / 64) * (DM / 32), I_PB = (768 / 64) * (DM / 32), I_O = (DM / 64) * (DM / 32),
                  I_F1 = (DM / 64) * (2 * DFF / 32), I_F2 = (DFF / 64) * (DM / 32);
    constexpr int NITEMS = I_IN + I_GLU + I_PA + 2 * I_PB + I_O + I_F1 + I_F2;
    for (int it = gw; it < NITEMS; it += NGW) {
        int r = it;
        if (r < I_IN) { const int nb = NCOLS_IN / 32, kb = r / nb, n0d = (r % nb) * 32; transpose_item(KIN(kp, I_WIN) + (size_t)l * DM * NCOLS_IN, DM, NCOLS_IN, (bf16_t*)(ws + WS_WIN), kb * 64, inproj_src_col(n0d), n0d, scr, F.lane); continue; } r -= I_IN;
        if (r < I_GLU) { const int nb = 768 / 32, kb = r / nb, n0 = (r % nb) * 32; transpose_item(KIN(kp, I_WGLU) + (size_t)l * 768 * 768, 768, 768, (bf16_t*)(ws + WS_WGLU), kb * 64, n0, n0, scr, F.lane); continue; } r -= I_GLU;
        if (r < I_PA) { const int nb = DM / 32, kb = r / nb, n0 = (r % nb) * 32; transpose_item(KIN(kp, I_WPA) + (size_t)l * 512 * DM, 512, DM, (bf16_t*)(ws + WS_WPA), kb * 64, n0, n0, scr, F.lane); continue; } r -= I_PA;
        if (r < I_PB) { const int nb = DM / 32, kb = r / nb, n0 = (r % nb) * 32; transpose_item(KIN(kp, I_WPB) + (size_t)l * 768 * DM, 768, DM, (bf16_t*)(ws + WS_WPB), kb * 64, n0, n0, scr, F.lane); continue; } r -= I_PB;
        if (r < I_PB) { const int nb = DM / 32, kb = r / nb, n0 = (r % nb) * 32; transpose_item(KIN(kp, I_WPC) + (size_t)l * 768 * DM, 768, DM, (bf16_t*)(ws + WS_WPC), kb * 64, n0, n0, scr, F.lane); continue; } r -= I_PB;
        if (r < I_O) { const int nb = DM / 32, kb = r / nb, n0 = (r % nb) * 32; transpose_item(KIN(kp, I_WO) + (size_t)l * DM * DM, DM, DM, (bf16_t*)(ws + WS_WO), kb * 64, n0, n0, scr, F.lane); continue; } r -= I_O;
        if (r < I_F1) { const int nb = 2 * DFF / 32, kb = r / nb, n0d = (r % nb) * 32; transpose_item(KIN(kp, I_WFF1) + (size_t)l * DM * 2 * DFF, DM, 2 * DFF, (bf16_t*)(ws + WS_WFF1), kb * 64, ff1_src_col(n0d), n0d, scr, F.lane); continue; } r -= I_F1;
        { const int nb = DM / 32, kb = r / nb, n0 = (r % nb) * 32; transpose_item(KIN(kp, I_WFF2) + (size_t)l * DFF * DM, DFF, DM, (bf16_t*)(ws + WS_WFF2), kb * 64, n0, n0, scr, F.lane); }
    }
    const int gt = F.vcu * 512 + F.tid, NGT = F.G * 512;
    if (l == 0) {
        const f32x4* x4 = (const f32x4*)KIN(kp, I_X); u32x2* o = (u32x2*)(ws + WS_XB);
        for (size_t i = gt; i < (size_t)MTOK * DM / 4; i += NGT) { const f32x4 v = x4[i]; u32x2 w; w.x = cvt_pk_bf16(v[0], v[1]); w.y = cvt_pk_bf16(v[2], v[3]); o[i] = w; }
    }
    { float* br = (float*)(ws + WS_MISC + MS_BIASR); const float* b = KIN(kp, I_BIN) + (size_t)l * NCOLS_IN;
      for (int i = gt; i < NCOLS_IN; i += NGT) br[i] = b[inproj_src_col(i)]; }
    { bf16_t* wt = (bf16_t*)(ws + WS_MISC + MS_WTRIL); const float* w = KIN(kp, I_WS) + (size_t)l * 6 * 128 * 128;
      for (int i = gt; i < 6 * 128 * 128 / 2; i += NGT) { const int e = 2 * i, t = (e >> 7) & 127, s = e & 127; const float w0 = (s <= t) ? w[e] : 0.f, w1 = (s + 1 <= t) ? w[e + 1] : 0.f; ((unsigned*)wt)[i] = cvt_pk_bf16(w0, w1); } }
}
__device__ __forceinline__ void phase_tables(const Frame& F, kptr_t kp) {
    unsigned char* ws = KWS(kp);
    const int gt0 = F.vcu * 512 + F.tid;
    if (gt0 < DEPTH * 48 * 64) {
        const int l = gt0 / 3072, gt = gt0 % 3072;
        const int g = gt >> 6;
        const double dt = exp((double)KIN(kp, I_LDT)[l * 48 + g]);
        const double lr = (double)KIN(kp, I_LRE)[(size_t)l * 3072 + gt], li = (double)KIN(kp, I_LIM)[(size_t)l * 3072 + gt];
        const double mag = exp(lr * dt), ang = li * dt;
        const double abr = mag * cos(ang), abi = mag * sin(ang);
        const double nrm = lr * lr + li * li;
        const double cr = ((abr - 1.0) * lr + abi * li) / nrm, ci = (abi * lr - (abr - 1.0) * li) / nrm;
        f32x2* BB = (f32x2*)(ws + WS_TAB + (size_t)l * TAB_LAYER + TAB_BB) + (size_t)gt * 16;
        const float* bre = KIN(kp, I_BRE) + ((size_t)l * 3072 + gt) * 16; const float* bim = KIN(kp, I_BIM) + ((size_t)l * 3072 + gt) * 16;
        for (int h = 0; h < 16; ++h) { const double br_ = bre[h], bi_ = bim[h]; BB[h] = (f32x2){(float)(cr * br_ - ci * bi_), (float)(cr * bi_ + ci * br_)}; }
        f32x2* PW = (f32x2*)(ws + WS_TAB + (size_t)l * TAB_LAYER + TAB_PW) + (size_t)gt * 65;
        double pr = 1.0, pi = 0.0;
        for (int j = 0; j <= 64; ++j) { PW[j] = (f32x2){(float)pr, (float)pi}; const double nr = pr * abr - pi * abi, ni = pr * abi + pi * abr; pr = nr; pi = ni; }
    }
}
__device__ __forceinline__ void phase_kj(const Frame& F, kptr_t kp, int l) {
    unsigned char* ws = KWS(kp);
    const int gt = F.vcu * 512 + F.tid, NGT = F.G * 512;
    const f32x2* PW = (const f32x2*)(ws + WS_TAB + (size_t)l * TAB_LAYER + TAB_PW); const f32x2* BB = (const f32x2*)(ws + WS_TAB + (size_t)l * TAB_LAYER + TAB_BB);
    const float* cre = KIN(kp, I_CRE) + (size_t)l * 48 * 16 * 64; const float* cim = KIN(kp, I_CIM) + (size_t)l * 48 * 16 * 64;
    float* KJ = (float*)(ws + WS_MISC + MS_KJ);
    for (int i = gt; i < 48 * 64 * 256; i += NGT) {
        const int h = i & 15, hp = (i >> 4) & 15, j = (i >> 8) & 63, g = i >> 14;
        float s = 0.f;
        for (int p = 0; p < 64; ++p) {
            const float c_r = cre[(g * 16 + hp) * 64 + p], c_i = cim[(g * 16 + hp) * 64 + p];
            const f32x2 pw = PW[(size_t)(g * 64 + p) * 65 + j], bb = BB[(size_t)(g * 64 + p) * 16 + h];
            const float wr_ = c_r * pw.x - c_i * pw.y, wi_ = c_r * pw.y + c_i * pw.x;
            s += wr_ * bb.x - wi_ * bb.y;
        }
        KJ[i] = s;
    }
}
__device__ __forceinline__ void phase_s5mats(const Frame& F, kptr_t kp, int l) {
    unsigned char* ws = KWS(kp);
    const int gt = F.vcu * 512 + F.tid, NGT = F.G * 512;
    const f32x2* PW = (const f32x2*)(ws + WS_TAB + (size_t)l * TAB_LAYER + TAB_PW); const f32x2* BB = (const f32x2*)(ws + WS_TAB + (size_t)l * TAB_LAYER + TAB_BB);
    const float* KJ = (const float*)(ws + WS_MISC + MS_KJ);
    bf16_t* BT = (bf16_t*)(ws + WS_S5BT);
    for (int i = gt; i < 48 * 1152 * 128; i += NGT) {
        const int ch = i & 127, row = (i >> 7) % 1152, g = (i >> 7) / 1152;
        const int k0 = ch * 8, s = k0 >> 4, h0 = k0 & 15;
        float v[8];
        if (row < 1024) {
            const int t = row >> 4, hp = row & 15;
            if (s <= t) { const float* kq = KJ + (((size_t)g * 64 + (t - s)) * 16 + hp) * 16 + h0; const f32x4 k0v = *(const f32x4*)kq, k1v = *(const f32x4*)(kq + 4);
                v[0] = k0v[0]; v[1] = k0v[1]; v[2] = k0v[2]; v[3] = k0v[3]; v[4] = k1v[0]; v[5] = k1v[1]; v[6] = k1v[2]; v[7] = k1v[3]; }
            else {
#pragma unroll
                for (int j = 0; j < 8; ++j) v[j] = 0.f; }
        } else {
            const int r2 = row - 1024, ri = r2 >> 6, p = r2 & 63;
            const f32x2 pw = PW[(size_t)(g * 64 + p) * 65 + (63 - s)];
#pragma unroll
            for (int j = 0; j < 8; ++j) { const f32x2 bb = BB[(size_t)(g * 64 + p) * 16 + h0 + j]; v[j] = ri ? (pw.x * bb.y + pw.y * bb.x) : (pw.x * bb.x - pw.y * bb.y); }
        }
        *(u32x4*)(BT + ((size_t)g * 1152 + row) * 1024 + k0) = pack8(v);
    }
    const float* cre = KIN(kp, I_CRE) + (size_t)l * 48 * 16 * 64; const float* cim = KIN(kp, I_CIM) + (size_t)l * 48 * 16 * 64;
    bf16_t* QM = (bf16_t*)(ws + WS_S5QM);
    for (int i = gt; i < 48 * 1024 * 32; i += NGT) {
        const int ch = i & 31, row = (i >> 5) & 1023, g = i >> 15;
        const int t = row >> 4, hp = row & 15, k0 = ch * 8;
        float v[8];
        if (k0 < 128) {
            const int ri = k0 >> 6, p0 = k0 & 63;
#pragma unroll
            for (int j = 0; j < 8; ++j) { const int p = p0 + j; const float c_r = cre[(g * 16 + hp) * 64 + p], c_i = cim[(g * 16 + hp) * 64 + p]; const f32x2 pw = PW[(size_t)(g * 64 + p) * 65 + t + 1];
                v[j] = ri ? -(c_r * pw.y + c_i * pw.x) : (c_r * pw.x - c_i * pw.y); }
        } else {
#pragma unroll
            for (int j = 0; j < 8; ++j) v[j] = 0.f;
        }
        *(u32x4*)(QM + ((size_t)g * 1024 + row) * 256 + k0) = pack8(v);
    }
}

constexpr int ATT_KROW = 144, ATT_VROW = 776;
constexpr int ATT_K_OFF = 0, ATT_V_OFF = 384 * ATT_KROW, ATT_TAB_OFF = ATT_V_OFF + 64 * ATT_VROW;
static_assert(ATT_TAB_OFF + 24 * 192 * 4 <= RING_BYTES, "attention LDS map");
__device__ __forceinline__ void phase_attention(const Frame& F, kptr_t kp, const bool dry) {
    unsigned char* ws = KWS(kp);
    LAS unsigned char* lk = F.lds + RING_OFF + ATT_K_OFF; LAS unsigned char* lv = F.lds + RING_OFF + ATT_V_OFF;
    LAS float* tab = (LAS float*)(F.lds + RING_OFF + ATT_TAB_OFF);
    const float* rel = KIN(kp, I_REL);
    for (int i = F.tid; i < 24 * 192; i += 512) { const int gh = i / 192, idx = i % 192, steps = idx - 31, g = gh >> 3;
        tab[i] = (steps >= 0 && steps <= 128) ? rel[(int)T5B[g][steps] * 24 + gh] * LOG2E : -1.0e30f; }
    bf16_t* Qb = (bf16_t*)(ws + WS_Q); const bf16_t* Kb = (const bf16_t*)(ws + WS_K); const bf16_t* VT = (const bf16_t*)(ws + WS_VT);
    const int lane = F.lane, q = lane & 31, hh = lane >> 5, w = F.wave;
    for (int u = F.vcu; u < 3072; u += F.G) {
        const int g = u >> 10, r = u & 1023, b = r >> 7, r2 = r & 127, h = r2 >> 4, blk8 = r2 & 15;
        const int dil = (g == 0) ? 1 : (g == 1 ? 4 : 16), Ls = SEQ / dil, nb8 = Ls / 256;
        const int c = blk8 / nb8, M0 = (blk8 % nb8) * 256, gh = g * 8 + h;
        const size_t tq = (size_t)b * SEQ + (size_t)(M0 + 32 * w + q) * dil + c;
        bf16_t* qrow = Qb + tq * 1536 + gh * 64;
        bf16x8 qf[4];
#pragma unroll
        for (int s = 0; s < 4; ++s) qf[s] = *(const bf16x8*)(qrow + s * 16 + hh * 8);
        { u32x4 kr[6], vr[6];
#pragma unroll
          for (int i = 0; i < 6; ++i) { const int idx = F.tid + 512 * i, row = idx >> 3, ch = idx & 7; int pos = M0 - 128 + row; pos = pos < 0 ? 0 : pos;
              kr[i] = *(const u32x4*)(Kb + ((size_t)b * SEQ + (size_t)pos * dil + c) * 1536 + gh * 64 + ch * 8); }
#pragma unroll
          for (int i = 0; i < 6; ++i) { const int idx = F.tid + 512 * i, dim = idx / 48, ch = idx % 48; int pos = M0 - 128 + ch * 8; pos = pos < 0 ? 0 : pos;
              vr[i] = *(const u32x4*)(VT + (size_t)(gh * 64 + dim) * MTOK + (size_t)b * SEQ + (size_t)c * Ls + pos); }
#pragma unroll
          for (int i = 0; i < 6; ++i) { const int idx = F.tid + 512 * i, row = idx >> 3, ch = idx & 7; *(LAS u32x4*)(lk + row * ATT_KROW + ch * 16) = kr[i]; }
#pragma unroll
          for (int i = 0; i < 6; ++i) { const int idx = F.tid + 512 * i, dim = idx / 48, ch = idx % 48; LAS unsigned char* d = lv + dim * ATT_VROW + ch * 16;
              *(LAS u32x2*)d = (u32x2){vr[i].x, vr[i].y}; *(LAS u32x2*)(d + 8) = (u32x2){vr[i].z, vr[i].w}; } }
        __syncthreads();
        const int jmin = (M0 == 0 && w < 4) ? 4 - w : 0;
        const LAS float* tb = tab + gh * 192;
        f32x16 sc[5];
        float mx = -3.0e38f;
#pragma unroll
        for (int j = 0; j < 5; ++j) {
            const LAS unsigned char* krow = lk + (32 * w + 32 * j + q) * ATT_KROW + hh * 16;
            f32x16 acc;
#pragma unroll
            for (int i = 0; i < 16; ++i) acc[i] = 0.f;
#pragma unroll
            for (int s = 0; s < 4; ++s) { const bf16x8 kf = *(const LAS bf16x8*)(krow + s * 32); acc = __builtin_amdgcn_mfma_f32_32x32x16_bf16(kf, qf[s], acc, 0, 0, 0); }
            const float tmask = (j < jmin) ? -1.0e30f : 0.f;
#pragma unroll
            for (int i = 0; i < 16; ++i) { const int ki = (i & 3) + 8 * (i >> 2) + 4 * hh; const float v = acc[i] + tb[159 + q - 32 * j - ki] + tmask; acc[i] = v; mx = fmaxf(mx, v); }
            sc[j] = acc;
        }
        mx = fmaxf(mx, shfl_xor_l(mx, 32, lane));
        float den = 0.f;
        f32x16 o0, o1;
#pragma unroll
        for (int i = 0; i < 16; ++i) { o0[i] = 0.f; o1[i] = 0.f; }
#pragma unroll
        for (int j = 0; j < 5; ++j) {
            float p[16];
#pragma unroll
            for (int i = 0; i < 16; ++i) { p[i] = __builtin_amdgcn_exp2f(sc[j][i] - mx); den += p[i]; }
#pragma unroll
            for (int s = 0; s < 2; ++s) {
                union { bf16x8 v; unsigned w4[4]; } pf;
#pragma unroll
                for (int e = 0; e < 4; ++e) pf.w4[e] = cvt_pk_bf16(p[8 * s + 2 * e], p[8 * s + 2 * e + 1]);
#pragma unroll
                for (int d = 0; d < 2; ++d) {
                    const LAS unsigned char* vrow = lv + (d * 32 + q) * ATT_VROW + (32 * w + 32 * j + 16 * s + 4 * hh) * 2;
                    union { bf16x8 v; u32x2 h2[2]; } vf;
                    vf.h2[0] = *(const LAS u32x2*)vrow; vf.h2[1] = *(const LAS u32x2*)(vrow + 16);
                    if (d == 0) o0 = __builtin_amdgcn_mfma_f32_32x32x16_bf16(vf.v, pf.v, o0, 0, 0, 0);
                    else        o1 = __builtin_amdgcn_mfma_f32_32x32x16_bf16(vf.v, pf.v, o1, 0, 0, 0);
                }
            }
        }
        den += shfl_xor_l(den, 32, lane);
        const float rden = 1.0f / den;
        bf16_t* orow = dry ? (bf16_t*)(ws + WS_YC) + tq * 1536 + gh * 64 : qrow;
#pragma unroll
        for (int d = 0; d < 2; ++d)
#pragma unroll
            for (int gq = 0; gq < 4; ++gq) { const f32x16& o = d ? o1 : o0; u32x2 wv; wv.x = cvt_pk_bf16(o[4 * gq] * rden, o[4 * gq + 1] * rden); wv.y = cvt_pk_bf16(o[4 * gq + 2] * rden, o[4 * gq + 3] * rden);
                *(u32x2*)(orow + d * 32 + 8 * gq + 4 * hh) = wv; }
        if (hh == 0 && !dry) ((float*)(ws + WS_LSE))[tq * 24 + gh] = (mx + __builtin_amdgcn_logf(den)) * LN2;
        __syncthreads();
    }
}

__device__ __forceinline__ void phase_gmlp(const Frame& F, kptr_t kp, int l) {
    unsigned char* ws = KWS(kp);
    LAS float* part = (LAS float*)(F.lds + RING_OFF);
    LAS f32x2* stat = (LAS f32x2*)(F.lds + RING_OFF + 32768);
    const bf16_t* VGT = (const bf16_t*)(ws + WS_VGT); const bf16_t* U = (const bf16_t*)(ws + WS_U); bf16_t* YB = (bf16_t*)(ws + WS_YB);
    const bf16_t* WT = (const bf16_t*)(ws + WS_MISC + MS_WTRIL);
    const float* lng = KIN(kp, I_SLNG) + l * 768; const float* lnb = KIN(kp, I_SLNB) + l * 768; const float* bs = KIN(kp, I_BS) + l * 768;
    const int lane = F.lane, q = lane & 31, hh = lane >> 5;
    for (int ck = F.vcu; ck < MTOK / 128; ck += F.G) {
        const size_t tok0 = (size_t)ck * 128;
        { const int t8 = (F.tid & 15) * 8, pt = F.tid >> 4; float sm[8], sq[8];
#pragma unroll
          for (int j = 0; j < 8; ++j) { sm[j] = 0.f; sq[j] = 0.f; }
#pragma unroll 6
          for (int i = 0; i < 24; ++i) { float v[8]; unpack8(*(const u32x4*)(VGT + (size_t)(pt * 24 + i) * MTOK + tok0 + t8), v);
#pragma unroll
              for (int j = 0; j < 8; ++j) { sm[j] += v[j]; sq[j] += v[j] * v[j]; } }
#pragma unroll
          for (int j = 0; j < 8; ++j) { part[(pt * 128 + t8 + j) * 2] = sm[j]; part[(pt * 128 + t8 + j) * 2 + 1] = sq[j]; } }
        __syncthreads();
        if (F.tid < 128) { float s = 0.f, s2 = 0.f;
#pragma unroll 8
            for (int pt = 0; pt < 32; ++pt) { s += part[(pt * 128 + F.tid) * 2]; s2 += part[(pt * 128 + F.tid) * 2 + 1]; }
            const float mean = s * (1.0f / 768.0f), var = fmaxf(s2 * (1.0f / 768.0f) - mean * mean, 0.f);
            stat[F.tid] = (f32x2){mean, 1.0f / sqrtf(var + LN_EPS)}; }
        __syncthreads();
        const int ct = F.wave & 3, tta = (F.wave >> 2) ? 1 : 0, ttb = (F.wave >> 2) ? 2 : 3;
        for (int g = 0; g < 6; ++g) {
            const int cch = g * 128 + ct * 32 + q;
            const float gg = lng[cch], gb = lnb[cch];
            const bf16_t* vrow = VGT + (size_t)cch * MTOK + tok0;
            const bf16_t* wa = WT + ((size_t)g * 128 + tta * 32 + q) * 128; const bf16_t* wb = WT + ((size_t)g * 128 + ttb * 32 + q) * 128;
            f32x16 ca, cb;
#pragma unroll
            for (int i = 0; i < 16; ++i) { ca[i] = 0.f; cb[i] = 0.f; }
#pragma unroll
            for (int ks = 0; ks < 8; ++ks) {
                const int s0 = 16 * ks + 8 * hh;
                float vv[8]; unpack8(*(const u32x4*)(vrow + s0), vv);
#pragma unroll
                for (int j = 0; j < 8; ++j) { const f32x2 st = stat[s0 + j]; vv[j] = (vv[j] - st.x) * st.y * gg + gb; }
                union { bf16x8 v; u32x4 w; } af; af.w = pack8(vv);
                const bf16x8 bfb = *(const bf16x8*)(wb + s0), bfa = *(const bf16x8*)(wa + s0);
                cb = __builtin_amdgcn_mfma_f32_32x32x16_bf16(af.v, bfb, cb, 0, 0, 0);
                ca = __builtin_amdgcn_mfma_f32_32x32x16_bf16(af.v, bfa, ca, 0, 0, 0);
            }
#pragma unroll
            for (int w2 = 0; w2 < 2; ++w2) {
                const int tt = w2 ? ttb : tta; const f32x16& cc = w2 ? cb : ca;
                const int t = tt * 32 + q; const float bsv = bs[g * 128 + t];
                const size_t rowoff = (tok0 + t) * 768 + g * 128 + ct * 32 + 4 * hh;
#pragma unroll
                for (int gq = 0; gq < 4; ++gq) { const u32x2 uw = *(const u32x2*)(U + rowoff + 8 * gq);
                    u32x2 w; w.x = cvt_pk_bf16(bf_lo(uw.x) * (cc[4 * gq] + bsv), bf_hi(uw.x) * (cc[4 * gq + 1] + bsv)); w.y = cvt_pk_bf16(bf_lo(uw.y) * (cc[4 * gq + 2] + bsv), bf_hi(uw.y) * (cc[4 * gq + 3] + bsv));
                    *(u32x2*)(YB + rowoff + 8 * gq) = w; }
            }
        }
        __syncthreads();
    }
}

__device__ __forceinline__ void phase_carry_combine(const Frame& F, kptr_t kp, int l) {
    unsigned char* ws = KWS(kp);
    const int gt = F.vcu * 512 + F.tid, NGT = F.G * 512;
    const f32x2* PW = (const f32x2*)(ws + WS_TAB + (size_t)l * TAB_LAYER + TAB_PW);
    const float* E = (const float*)(ws + WS_E); bf16_t* XIN = (bf16_t*)(ws + WS_XIN);
    for (int i = gt; i < BATCH * 48 * 64; i += NGT) {
        const int p = i & 63, g = (i >> 6) % 48, b = (i >> 6) / 48;
        const f32x2 aT = PW[(size_t)(g * 64 + p) * 65 + 64];
        float xr = 0.f, xi = 0.f;
        for (int c = 0; c < 64; ++c) {
            const int n = b * 64 + c;
            bf16_t* xo = XIN + ((size_t)g * 512 + n) * 256;
            xo[p] = (bf16_t)(cvt_pk_bf16(xr, 0.f) & 0xffffu); xo[64 + p] = (bf16_t)(cvt_pk_bf16(xi, 0.f) & 0xffffu); xo[128 + p] = 0; xo[192 + p] = 0;
            const float er = E[((size_t)n * 48 + g) * 128 + p], ei = E[((size_t)n * 48 + g) * 128 + 64 + p];
            const float nr = aT.x * xr - aT.y * xi + er, ni = aT.x * xi + aT.y * xr + ei; xr = nr; xi = ni;
        }
    }
    const bf16_t* O = (const bf16_t*)(ws + WS_Q); const float* LSE = (const float*)(ws + WS_LSE); bf16_t* YA = (bf16_t*)(ws + WS_YA);
    for (size_t i = gt; i < (size_t)MTOK * 64; i += NGT) {
        const size_t tok = i >> 6; const int h = (int)(i >> 3) & 7, ch = (int)i & 7;
        const float l0 = LSE[tok * 24 + h], l1 = LSE[tok * 24 + 8 + h], l2 = LSE[tok * 24 + 16 + h];
        const float mx = fmaxf(l0, fmaxf(l1, l2));
        float w0 = __builtin_amdgcn_exp2f((l0 - mx) * LOG2E), w1 = __builtin_amdgcn_exp2f((l1 - mx) * LOG2E), w2 = __builtin_amdgcn_exp2f((l2 - mx) * LOG2E);
        const float rs = 1.0f / (w0 + w1 + w2); w0 *= rs; w1 *= rs; w2 *= rs;
        float o0[8], o1[8], o2[8];
        unpack8(*(const u32x4*)(O + tok * 1536 + h * 64 + ch * 8), o0); unpack8(*(const u32x4*)(O + tok * 1536 + 512 + h * 64 + ch * 8), o1); unpack8(*(const u32x4*)(O + tok * 1536 + 1024 + h * 64 + ch * 8), o2);
#pragma unroll
        for (int j = 0; j < 8; ++j) o0[j] = w0 * o0[j] + w1 * o1[j] + w2 * o2[j];
        *(u32x4*)(YA + tok * 512 + h * 64 + ch * 8) = pack8(o0);
    }
}

__device__ __forceinline__ void phase_ln(const Frame& F, kptr_t kp, const float* gam, const float* bet, bool write_bf16) {
    const int gw = F.vcu * NWAVES + F.wave, NGW = F.G * NWAVES;
    bf16_t* XB = (bf16_t*)(KWS(kp) + WS_XB);
    for (int r = gw; r < MTOK; r += NGW) {
        f32x4* xr = (f32x4*)(KOUT(kp) + (size_t)r * DM) + F.lane;
        f32x4 v[8]; float s = 0.f;
#pragma unroll
        for (int j = 0; j < 8; ++j) { v[j] = xr[64 * j]; s += (v[j][0] + v[j][1]) + (v[j][2] + v[j][3]); }
        const float mean = wave_sum(s, F.lane) * (1.0f / DM); float s2 = 0.f;
#pragma unroll
        for (int j = 0; j < 8; ++j) { v[j] = v[j] - mean; s2 += (v[j][0] * v[j][0] + v[j][1] * v[j][1]) + (v[j][2] * v[j][2] + v[j][3] * v[j][3]); }
        const float rstd = 1.0f / sqrtf(wave_sum(s2, F.lane) * (1.0f / DM) + LN_EPS);
        u32x2* ob = (u32x2*)(XB + (size_t)r * DM) + F.lane;
#pragma unroll
        for (int j = 0; j < 8; ++j) { const f32x4 gg = *((const f32x4*)gam + F.lane + 64 * j), bb = *((const f32x4*)bet + F.lane + 64 * j);
            const f32x4 o = v[j] * rstd * gg + bb; xr[64 * j] = o;
            if (write_bf16) { u32x2 w; w.x = cvt_pk_bf16(o[0], o[1]); w.y = cvt_pk_bf16(o[2], o[3]); ob[64 * j] = w; } }
    }
}

__global__ void __launch_bounds__(NWAVES * 64, 2) mk_fwd(Args args) {
    extern __shared__ __attribute__((aligned(16))) unsigned char lds_raw[];
    LAS unsigned char* const lds = (LAS unsigned char*)lds_raw;
    int wave_s = __builtin_amdgcn_readfirstlane((int)threadIdx.x >> 6); asm volatile("" : "+s"(wave_s));
    for (int u = threadIdx.x; u < (LDS_BYTES - LDSCTL_OFF) / 4; u += NWAVES * 64) ((LAS unsigned*)(lds + LDSCTL_OFF))[u] = 0u;
    __syncthreads();
#if MK_MULTI
#define GRID_BAR() do {} while (0)
#else
    (void)xcd_barrier_post((unsigned*)(args.ws + WS_CTL) + CW_BAR, (volatile LAS unsigned*)(lds + MISC_OFF) + 8);
#define GRID_BAR() do { PH_REFRESH(); unsigned* bp_ = (unsigned*)(ws + WS_CTL) + CW_BAR; asm volatile("" : "+s"(bp_)); XcdBarrier b_; b_.bar = bp_; b_.x = xb_xcc_id(); b_.st = (volatile LAS unsigned*)(lds + MISC_OFF) + 8; xcd_barrier(b_, F.tid == 0); } while (0)
#endif
    const int lo = args.ph_lo, hi = args.ph_hi;
#define IN(k) (lo <= (k) && (k) < hi)
#define SEAM(k) do { if (IN((k) + 1)) GRID_BAR(); } while (0)
    LAS unsigned char* const ring = lds + RING_OFF;

#define PH_BEGIN() kptr_t kp = (kptr_t)__builtin_amdgcn_kernarg_segment_ptr(); asm volatile("" : "+s"(kp)); unsigned char* ws = KWS(kp); \
        int bx = (int)blockIdx.x; asm volatile("" : "+s"(bx)); unsigned wz_ = (unsigned)wave_s << 6; asm volatile("" : "+s"(wz_)); int tid_ = (int)__builtin_amdgcn_mbcnt_hi(~0u, __builtin_amdgcn_mbcnt_lo(~0u, wz_)); int G_ = (int)gridDim.x; asm volatile("" : "+s"(G_)); \
        Frame F; F.lds = lds; F.tid = tid_; F.lane = tid_ & 63; F.wave = wave_s; F.G = G_; F.vcu = (G_ % 8 == 0) ? (bx % 8) * (G_ / 8) + bx / 8 : bx;
#define PH_REFRESH() do { unsigned wz2_ = (unsigned)wave_s << 6; asm volatile("" : "+s"(wz2_)); F.tid = (int)__builtin_amdgcn_mbcnt_hi(~0u, __builtin_amdgcn_mbcnt_lo(~0u, wz2_)); F.lane = F.tid & 63; } while (0)
    if (IN(0)) { PH_BEGIN(); phase_tables(F, kp); SEAM(0); }
    for (int l = 0; l < DEPTH; ++l) {
        const int pb = 1 + l * NPH;
        if (IN(pb + 0)) { PH_BEGIN(); REP(0) phase_convert(F, kp, l); SEAM(pb + 0); }
        if (IN(pb + 1)) { PH_BEGIN(); phase_kj(F, kp, l); SEAM(pb + 1); }
        if (IN(pb + 2)) { PH_BEGIN(); phase_s5mats(F, kp, l); SEAM(pb + 2); }
        if (IN(pb + 3)) { PH_BEGIN(); REP(3) {
            const float* biasr = (const float*)(ws + WS_MISC + MS_BIASR);
            { pg8::DenseSched S; S.init(ws + WS_XB, ws + WS_WIN, MTOK, 10752, DM, F.G, bx);
              EpiInProj E{(bf16_t*)(ws + WS_Q), (bf16_t*)(ws + WS_K), (bf16_t*)(ws + WS_U), (bf16_t*)(ws + WS_UC), (bf16_t*)(ws + WS_GATES), biasr};
              pg8::gemm_phase(F.tid, ring, DM, pg8::dense_op(DM), pg8::dense_op(DM), S, E); }
            PH_REFRESH();
            { pg8::SwapSched S; S.nM = 5; S.nwg = 5 * 128; S.G = F.G; S.c = bx; S.dil = 1; S.W = (const char*)(ws + WS_WIN) + (size_t)10752 * DM * 2; S.X = (const char*)(ws + WS_XB);
              EpiSwap E{(bf16_t*)(ws + WS_VT), (bf16_t*)(ws + WS_VGT), biasr + 10752, 2};
              pg8::OpDesc dB = pg8::dense_op(DM);
              pg8::gemm_phase(F.tid, ring, DM, pg8::dense_op(DM), dB, S, E); }
            PH_REFRESH();
            { pg8::SwapSched S; S.nM = 2; S.nwg = 2 * 128; S.G = F.G; S.c = bx; S.dil = 4; S.W = (const char*)(ws + WS_WIN) + (size_t)12032 * DM * 2; S.X = (const char*)(ws + WS_XB);
              EpiSwap E{(bf16_t*)(ws + WS_VT) + (size_t)512 * MTOK, (bf16_t*)(ws + WS_VGT), biasr + 12032, 2};
              pg8::OpDesc dB = pg8::dense_op(DM); dB.rs = 4u * DM * 2u;
              pg8::gemm_phase(F.tid, ring, DM, pg8::dense_op(DM), dB, S, E); }
            PH_REFRESH();
            { pg8::SwapSched S; S.nM = 2; S.nwg = 2 * 128; S.G = F.G; S.c = bx; S.dil = 16; S.W = (const char*)(ws + WS_WIN) + (size_t)12544 * DM * 2; S.X = (const char*)(ws + WS_XB);
              EpiSwap E{(bf16_t*)(ws + WS_VT) + (size_t)1024 * MTOK, (bf16_t*)(ws + WS_VGT), biasr + 12544, 2};
              pg8::OpDesc dB = pg8::dense_op(DM); dB.rs = 16u * DM * 2u;
              pg8::gemm_phase(F.tid, ring, DM, pg8::dense_op(DM), dB, S, E); }
            PH_REFRESH(); }
            SEAM(pb + 3);
        }
        if (IN(pb + 4)) { PH_BEGIN();
            { pg8::GroupSched S; S.nM = 2; S.nN = 5; S.nwg = 480; S.G = F.G; S.c = bx;
              S.A = (const char*)(ws + WS_UC); S.gA = 32; S.tA = (size_t)256 * 49152 * 2;
              S.B = (const char*)(ws + WS_S5BT); S.gB = (size_t)1152 * 1024 * 2; S.tB = (size_t)256 * 1024 * 2;
              pg8::OpDesc dA; dA.rs = 49152u * 2u; dA.ks = 4u * 768u * 2u; dA.cshift = 4; dA.cstride = 768u * 2u;
              EpiS5A E{(bf16_t*)(ws + WS_YI), (float*)(ws + WS_E)};
              pg8::gemm_phase(F.tid, ring, 1024, dA, pg8::dense_op(1024), S, E); }
            PH_REFRESH();
            REP(41) phase_gmlp(F, kp, l);
            if ((MK_REPEAT) == 42) phase_attention(F, kp, true);
            phase_attention(F, kp, false);
            SEAM(pb + 4);
        }
        if (IN(pb + 5)) { PH_BEGIN(); REP(5) phase_carry_combine(F, kp, l); SEAM(pb + 5); }
        if (IN(pb + 6)) { PH_BEGIN();
            pg8::GroupSched S; S.nM = 2; S.nN = 4; S.nwg = 384; S.G = F.G; S.c = bx;
            S.A = (const char*)(ws + WS_XIN); S.gA = (size_t)512 * 256 * 2; S.tA = (size_t)256 * 256 * 2;
            S.B = (const char*)(ws + WS_S5QM); S.gB = (size_t)1024 * 256 * 2; S.tB = (size_t)256 * 256 * 2;
            EpiS5B E{(const bf16_t*)(ws + WS_YI), (const bf16_t*)(ws + WS_UC), KIN(kp, I_DSK) + l * 768, (bf16_t*)(ws + WS_YC)};
            pg8::gemm_phase(F.tid, ring, 256, pg8::dense_op(256), pg8::dense_op(256), S, E);
            SEAM(pb + 6);
        }
        if (IN(pb + 7)) { PH_BEGIN();
            pg8::DenseSched S; S.init(ws + WS_YC, ws + WS_WGLU, MTOK, 768, 768, F.G, bx);
            EpiGlu E{(const bf16_t*)(ws + WS_YC), KIN(kp, I_BGLU) + l * 768, (bf16_t*)(ws + WS_YC2)};
            pg8::gemm_phase(F.tid, ring, 768, pg8::dense_op(768), pg8::dense_op(768), S, E);
            SEAM(pb + 7);
        }
        if (IN(pb + 8)) { PH_BEGIN();
            { pg8::DenseSched S; S.init(ws + WS_YA, ws + WS_WPA, MTOK, DM, 512, F.G, bx);
              EpiMerge<false> E{(const bf16_t*)(ws + WS_GATES), (bf16_t*)(ws + WS_MERGED)};
              pg8::gemm_phase(F.tid, ring, 512, pg8::dense_op(512), pg8::dense_op(512), S, E); }
            PH_REFRESH();
            { pg8::DenseSched S; S.init(ws + WS_YB, ws + WS_WPB, MTOK, DM, 768, F.G, bx);
              EpiMerge<true> E{(const bf16_t*)(ws + WS_GATES) + 2048, (bf16_t*)(ws + WS_MERGED)};
              pg8::gemm_phase(F.tid, ring, 768, pg8::dense_op(768), pg8::dense_op(768), S, E); }
            PH_REFRESH();
            { pg8::DenseSched S; S.init(ws + WS_YC2, ws + WS_WPC, MTOK, DM, 768, F.G, bx);
              EpiMerge<true> E{(const bf16_t*)(ws + WS_GATES) + 4096, (bf16_t*)(ws + WS_MERGED)};
              pg8::gemm_phase(F.tid, ring, 768, pg8::dense_op(768), pg8::dense_op(768), S, E); }
            SEAM(pb + 8);
        }
        if (IN(pb + 9)) { PH_BEGIN();
            pg8::DenseSched S; S.init(ws + WS_MERGED, ws + WS_WO, MTOK, DM, DM, F.G, bx);
            EpiResid E{(l == 0) ? KIN(kp, I_X) : (const float*)KOUT(kp), KOUT(kp)};
            pg8::gemm_phase(F.tid, ring, DM, pg8::dense_op(DM), pg8::dense_op(DM), S, E);
            SEAM(pb + 9);
        }
        if (IN(pb + 10)) { PH_BEGIN(); phase_ln(F, kp, KIN(kp, I_LN1G) + l * DM, KIN(kp, I_LN1B) + l * DM, true); SEAM(pb + 10); }
        if (IN(pb + 11)) { PH_BEGIN();
            pg8::DenseSched S; S.init(ws + WS_XB, ws + WS_WFF1, MTOK, 2 * DFF, DM, F.G, bx);
            EpiSwiglu E{(bf16_t*)(ws + WS_H)};
            pg8::gemm_phase(F.tid, ring, DM, pg8::dense_op(DM), pg8::dense_op(DM), S, E);
            SEAM(pb + 11);
        }
        if (IN(pb + 12)) { PH_BEGIN();
            pg8::DenseSched S; S.init(ws + WS_H, ws + WS_WFF2, MTOK, DM, DFF, F.G, bx);
            EpiResid E{(const float*)KOUT(kp), KOUT(kp)};
            pg8::gemm_phase(F.tid, ring, DFF, pg8::dense_op(DFF), pg8::dense_op(DFF), S, E);
            SEAM(pb + 12);
        }
        if (IN(pb + 13)) { PH_BEGIN(); phase_ln(F, kp, KIN(kp, I_LN2G) + l * DM, KIN(kp, I_LN2B) + l * DM, l + 1 < DEPTH); SEAM(pb + 13); }
    }
#undef IN
#undef SEAM
}

extern "C" void kernel_launch(void* const* d_in, const int* in_sizes, int n_in, void* d_out, int out_size, void* d_ws, size_t ws_size, hipStream_t stream) {
    static int grid = 0;
    if (grid == 0) {
        if (n_in != 28 || out_size != MTOK * DM || ws_size < WS_END) { fprintf(stderr, "kernel_launch: unexpected problem (n_in %d, out %d, ws %zu, need %zu)\n", n_in, out_size, ws_size, (size_t)WS_END); grid = -1; return; }
        int dev = 0, cus = 0, per_cu = 0;
        if (hipGetDevice(&dev) != hipSuccess || hipDeviceGetAttribute(&cus, hipDeviceAttributeMultiprocessorCount, dev) != hipSuccess) { grid = -1; return; }
        if (hipFuncSetAttribute((const void*)mk_fwd, hipFuncAttributeMaxDynamicSharedMemorySize, LDS_BYTES) != hipSuccess) { fprintf(stderr, "kernel_launch: hipFuncSetAttribute failed\n"); grid = -1; return; }
        if (hipOccupancyMaxActiveBlocksPerMultiprocessor(&per_cu, (const void*)mk_fwd, NWAVES * 64, LDS_BYTES) != hipSuccess || per_cu < 1) { fprintf(stderr, "kernel_launch: occupancy query says %d\n", per_cu); }
        (void)hipGetLastError();
        grid = cus;
    }
    if (grid < 0) return;
    (void)hipMemsetAsync((char*)d_ws + WS_CTL, 0, CTL_ZERO_BYTES, stream);
    Args a{};
    for (int i = 0; i < 28; ++i) a.in[i] = (const float*)d_in[i];
    a.out = (float*)d_out; a.ws = (unsigned char*)d_ws;
#if MK_MULTI
    for (int p = 0; p < 1 + DEPTH * NPH; ++p) { a.ph_lo = p; a.ph_hi = p + 1; hipLaunchKernelGGL(mk_fwd, dim3(grid), dim3(NWAVES * 64), LDS_BYTES, stream, a); }
#else
    a.ph_lo = 0; a.ph_hi = 1 + DEPTH * NPH;
    hipLaunchKernelGGL(mk_fwd, dim3(grid), dim3(NWAVES * 64), LDS_BYTES, stream, a);
#endif
    const hipError_t le = hipPeekAtLastError();
    if (le != hipSuccess) fprintf(stderr, "kernel_launch: launch failed: %s\n", hipGetErrorName(le));
}
```

```cpp
#include <hip/hip_runtime.h>
#include <cstdio>
#include <cstdint>

#ifndef MK_MULTI
#define MK_MULTI 0
#endif

#ifndef MK_REPEAT
#define MK_REPEAT (-1)
#endif
#define REP(tag) for (int rep_ = 0; rep_ < ((MK_REPEAT) == (tag) ? 2 : 1); ++rep_)
#define GAS __attribute__((address_space(1)))
#define LAS __attribute__((address_space(3)))
typedef unsigned short bf16_t;
typedef short bf16x8 __attribute__((ext_vector_type(8)));
typedef float f32x4 __attribute__((ext_vector_type(4)));
typedef float f32x2 __attribute__((ext_vector_type(2)));
typedef float f32x16 __attribute__((ext_vector_type(16)));
typedef unsigned u32x4 __attribute__((ext_vector_type(4)));
typedef unsigned u32x2 __attribute__((ext_vector_type(2)));

constexpr int DM = 2048, BATCH = 8, SEQ = 4096, DEPTH = 4, MTOK = BATCH * SEQ;
constexpr int NCOLS_IN = 13056, DFF = 5632;
constexpr float ALPHA = 1.681792830507429f;
constexpr float LN_EPS = 1e-5f;
constexpr float LOG2E = 1.4426950408889634f, LN2 = 0.6931471805599453f;
constexpr int NPH = 12;

__device__ const unsigned char T5B[3][129] = {
 {0,1,2,3,4,5,6,7,8,9,10,11,12,13,14,15,16,16,16,16,16,16,17,17,17,17,17,17,17,17,18,18,18,18,18,18,18,18,18,18,19,19,19,19,19,19,19,19,19,19,19,19,19,19,20,20,20,20,20,20,20,20,20,20,20,20,20,20,20,20,20,20,20,21,21,21,21,21,21,21,21,21,21,21,21,21,21,21,21,21,21,21,21,21,21,21,21,21,21,22,22,22,22,22,22,22,22,22,22,22,22,22,22,22,22,22,22,22,22,22,22,22,22,22,22,22,22,22,22},
 {0,4,8,12,16,16,17,17,18,18,19,19,19,19,20,20,20,20,20,21,21,21,21,21,21,22,22,22,22,22,22,22,22,22,23,23,23,23,23,23,23,23,23,23,23,23,24,24,24,24,24,24,24,24,24,24,24,24,24,24,24,24,25,25,25,25,25,25,25,25,25,25,25,25,25,25,25,25,25,25,25,25,25,26,26,26,26,26,26,26,26,26,26,26,26,26,26,26,26,26,26,26,26,26,26,26,26,26,26,26,26,26,26,27,27,27,27,27,27,27,27,27,27,27,27,27,27,27,27},
 {0,16,18,19,20,21,21,22,22,23,23,23,24,24,24,24,25,25,25,25,25,26,26,26,26,26,26,26,26,27,27,27,27,27,27,27,27,27,27,28,28,28,28,28,28,28,28,28,28,28,28,28,29,29,29,29,29,29,29,29,29,29,29,29,29,29,29,29,29,29,30,30,30,30,30,30,30,30,30,30,30,30,30,30,30,30,30,30,30,30,30,30,30,30,30,31,31,31,31,31,31,31,31,31,31,31,31,31,31,31,31,31,31,31,31,31,31,31,31,31,31,31,31,31,31,31,31,31,31}};

typedef __bf16 bf16x2_t __attribute__((ext_vector_type(2)));
__device__ __forceinline__ unsigned cvt_pk_bf16(float lo, float hi) { const f32x2 v = {lo, hi}; return __builtin_bit_cast(unsigned, __builtin_convertvector(v, bf16x2_t)); }
__device__ __forceinline__ float bf_lo(unsigned w) { return __uint_as_float(w << 16); }
__device__ __forceinline__ float bf_hi(unsigned w) { return __uint_as_float(w & 0xffff0000u); }
__device__ __forceinline__ float fast_sigmoid(float x) { return __builtin_amdgcn_rcpf(1.0f + __builtin_amdgcn_exp2f(-LOG2E * x)); }
__device__ __forceinline__ float gelu_tanh(float x) {
    const float u = x * (1.0f + 0.044715f * x * x);
    return x * __builtin_amdgcn_rcpf(1.0f + __builtin_amdgcn_exp2f(-2.0f * 0.7978845608028654f * LOG2E * u));
}
__device__ __forceinline__ float silu(float x) { return x * fast_sigmoid(x); }
__device__ __forceinline__ void unpack8(const u32x4 w, float (&f)[8]) {
    f[0] = bf_lo(w.x); f[1] = bf_hi(w.x); f[2] = bf_lo(w.y); f[3] = bf_hi(w.y); f[4] = bf_lo(w.z); f[5] = bf_hi(w.z); f[6] = bf_lo(w.w); f[7] = bf_hi(w.w);
}
__device__ __forceinline__ u32x4 pack8(const float (&f)[8]) {
    u32x4 w; w.x = cvt_pk_bf16(f[0], f[1]); w.y = cvt_pk_bf16(f[2], f[3]); w.z = cvt_pk_bf16(f[4], f[5]); w.w = cvt_pk_bf16(f[6], f[7]); return w;
}
__device__ __forceinline__ float shfl_xor_l(float v, int o, int lane) { return __int_as_float(__builtin_amdgcn_ds_bpermute((lane ^ o) << 2, __float_as_int(v))); }
__device__ __forceinline__ float wave_sum(float v, int lane) {
#pragma unroll
    for (int o = 1; o < 64; o <<= 1) v += shfl_xor_l(v, o, lane);
    return v;
}

namespace pg8 {
constexpr int BM = 256, BK = 64, HALF = 128, HTB = HALF * BK * 2, STAGE_BYTES = 8 * HTB, NXCD = 8, WGM = 4;
__host__ __device__ __forceinline__ int lds_byte(int r, int c) { const int st = (r >> 4) * 2 + (c >> 5), rr = r & 15, cc = c & 31, ob = rr * 64 + cc * 2; return st * 1024 + (ob ^ (((ob >> 9) & 1) << 5)); }
__host__ __device__ __forceinline__ void stage_rc(int b, int& R, int& C) { const int st = b / 1024, sb = b % 1024, swz = sb ^ (((sb >> 9) & 1) << 5); R = (st >> 1) * 16 + swz / 64; C = (st & 1) * 32 + (swz % 64) / 2; }
__host__ __device__ __forceinline__ int perm32(int rho) { const int n = rho >> 4, i = rho & 15; return 8 * (i >> 2) + 4 * n + (i & 3); }

struct Unit { int pm, pn, g; };
struct OpDesc { unsigned rs, ks; int cshift; unsigned cstride; };
__device__ __forceinline__ OpDesc dense_op(int K) { OpDesc d; d.rs = (unsigned)K * 2u; d.ks = 128u; d.cshift = 6; d.cstride = 0u; return d; }
__device__ __forceinline__ unsigned op_off(const OpDesc& d, int R, int C) { return (unsigned)R * d.rs + (unsigned)(C >> d.cshift) * d.cstride + (unsigned)(C & ((1 << d.cshift) - 1)) * 2u; }

template <class Epi, class Sched>
__device__ __forceinline__ void gemm_phase(const int tid_in, LAS unsigned char* lds, const int K, const OpDesc dA, const OpDesc dB, const Sched& S, const Epi& E) {
    int tid = tid_in; asm volatile("" : "+v"(tid));
    const int wid = __builtin_amdgcn_readfirstlane(tid >> 6), lane = tid & 63, wr = wid >> 2, wc = wid & 3, fr = lane & 15, fq = lane >> 4;
    unsigned voffA[2], voffB[2];
#pragma unroll
    for (int i = 0; i < 2; ++i) { int R, C; stage_rc(tid * 16 + i * 8192, R, C); const int Rb = Epi::PERM ? ((R & ~31) + perm32(R & 31)) : R;
        voffA[i] = op_off(dA, R, C); voffB[i] = op_off(dB, Rb, C); }
    const size_t kstepA = dA.ks, kstepB = dB.ks;
    const size_t hstepA = (size_t)HALF * dA.rs, hstepB = (size_t)HALF * dB.rs;
    const unsigned ldsw = (unsigned)wid * 1024u;
    const int aoff = lds_byte(wr * 64 + fr, fq * 8), boff = lds_byte(wc * 32 + fr, fq * 8);
#define PG8_SA(b, h) (((b) * 2 + (h)) * HTB)
#define PG8_SB(b, h) ((4 + (b) * 2 + (h)) * HTB)
#define PG8_STAGE(bufoff, gbase, voff) do { _Pragma("unroll") for (int _i = 0; _i < 2; ++_i) \
        __builtin_amdgcn_global_load_lds((const unsigned*)((const char*)(gbase) + (voff)[_i]), (LAS unsigned*)(lds + (bufoff) + ldsw + _i * 8192), 16, 0, 0); } while (0)
#define PG8_LDA(dst, b, h) do { _Pragma("unroll") for (int m = 0; m < 4; ++m) _Pragma("unroll") for (int k = 0; k < 2; ++k) dst[m][k] = *(const LAS bf16x8*)(lds + PG8_SA(b, h) + aoff + m * 2048 + k * 1024); } while (0)
#define PG8_LDB(dst, b, h) do { _Pragma("unroll") for (int n = 0; n < 2; ++n) _Pragma("unroll") for (int k = 0; k < 2; ++k) dst[n][k] = *(const LAS bf16x8*)(lds + PG8_SB(b, h) + boff + n * 2048 + k * 1024); } while (0)
#define PG8_MMA(ai, bj, At, Bt) do { __builtin_amdgcn_s_setprio(1); _Pragma("unroll") for (int m = 0; m < 4; ++m) _Pragma("unroll") for (int n = 0; n < 2; ++n) _Pragma("unroll") for (int k = 0; k < 2; ++k) \
        acc[ai][bj][m][n] = __builtin_amdgcn_mfma_f32_16x16x32_bf16(Bt[n][k], At[m][k], acc[ai][bj][m][n], 0, 0, 0); __builtin_amdgcn_s_setprio(0); } while (0)
#define PG8_WAIT_V(n) asm volatile("s_waitcnt vmcnt(" #n ")" ::: "memory")
#define PG8_WAIT_L(n) asm volatile("s_waitcnt lgkmcnt(" #n ")" ::: "memory")
#define PG8_BAR __builtin_amdgcn_s_barrier()
#define PG8_SCHED __builtin_amdgcn_sched_barrier(0)
    Unit cur, nxt; int ui = 0;
    if (!S.next(0, cur)) return;
    f32x4 acc[2][2][4][2];
#pragma unroll
    for (int a = 0; a < 2; ++a)
#pragma unroll
        for (int b = 0; b < 2; ++b)
#pragma unroll
            for (int m = 0; m < 4; ++m)
#pragma unroll
                for (int n = 0; n < 2; ++n) acc[a][b][m][n] = (f32x4){0.f, 0.f, 0.f, 0.f};
    bf16x8 At[4][2], B0[2][2], B1[2][2];
    const char* cA = S.pA(cur); const char* cB = S.pB(cur);
    PG8_STAGE(PG8_SB(0, 0), cB, voffB); PG8_STAGE(PG8_SB(0, 1), cB + hstepB, voffB); PG8_STAGE(PG8_SA(0, 0), cA, voffA); PG8_STAGE(PG8_SA(0, 1), cA + hstepA, voffA);
    if (wr == 1) PG8_BAR;
    PG8_WAIT_V(2); PG8_BAR;
    PG8_STAGE(PG8_SB(1, 0), cB + kstepB, voffB); PG8_STAGE(PG8_SA(1, 0), cA + kstepA, voffA); PG8_STAGE(PG8_SB(1, 1), cB + hstepB + kstepB, voffB);
    PG8_WAIT_V(6); PG8_BAR;
    for (;;) {
        const int nt = S.ntiles(cur, K / BK);
        const bool has_next = S.next(ui + 1, nxt);
        const char* nA = has_next ? S.pA(nxt) : cA; const char* nB = has_next ? S.pB(nxt) : cB;
        for (int t = 0; t < nt; t += 2) {
            const bool last = (t == nt - 2);
            const char* a1 = cA + (size_t)(t + 1) * kstepA;
            const char* a2 = last ? nA : cA + (size_t)(t + 2) * kstepA; const char* b2 = last ? nB : cB + (size_t)(t + 2) * kstepB;
            const char* a3 = a2 + kstepA; const char* b3 = b2 + kstepB;
            PG8_LDB(B0, 0, 0); PG8_LDB(B1, 0, 1); PG8_SCHED; PG8_LDA(At, 0, 0); PG8_STAGE(PG8_SA(1, 1), a1 + hstepA, voffA);
            PG8_WAIT_V(8); PG8_WAIT_L(0); PG8_BAR; PG8_MMA(0, 0, At, B0); PG8_MMA(0, 1, At, B1); PG8_BAR; PG8_SCHED;
            PG8_LDA(At, 0, 1); PG8_STAGE(PG8_SB(0, 0), b2, voffB); PG8_STAGE(PG8_SB(0, 1), b2 + hstepB, voffB); PG8_STAGE(PG8_SA(0, 0), a2, voffA);
            PG8_WAIT_V(8); PG8_WAIT_L(0); PG8_BAR; PG8_MMA(1, 0, At, B0); PG8_MMA(1, 1, At, B1); PG8_BAR; PG8_SCHED;
            PG8_LDB(B0, 1, 0); PG8_LDB(B1, 1, 1); PG8_SCHED; PG8_LDA(At, 1, 0); PG8_STAGE(PG8_SA(0, 1), a2 + hstepA, voffA);
            PG8_WAIT_V(8); PG8_WAIT_L(0); PG8_BAR; PG8_MMA(0, 0, At, B0); PG8_MMA(0, 1, At, B1); PG8_BAR; PG8_SCHED;
            PG8_LDA(At, 1, 1); PG8_STAGE(PG8_SB(1, 0), b3, voffB); PG8_STAGE(PG8_SB(1, 1), b3 + hstepB, voffB); PG8_STAGE(PG8_SA(1, 0), a3, voffA);
            PG8_WAIT_V(8); PG8_WAIT_L(0); PG8_BAR; PG8_MMA(1, 0, At, B0); PG8_MMA(1, 1, At, B1); PG8_BAR; PG8_SCHED;
        }
        if (wr == 0) PG8_BAR;
        E(acc, cur, wr, wc, fr, fq);
        if (!has_next) break;
#pragma unroll
        for (int a = 0; a < 2; ++a)
#pragma unroll
            for (int b = 0; b < 2; ++b)
#pragma unroll
                for (int m = 0; m < 4; ++m)
#pragma unroll
                    for (int n = 0; n < 2; ++n) acc[a][b][m][n] = (f32x4){0.f, 0.f, 0.f, 0.f};
        cur = nxt; cA = nA; cB = nB; ++ui;
        if (wr == 1) PG8_BAR;
    }
    PG8_WAIT_V(0);
    PG8_BAR;
#undef PG8_SA
#undef PG8_SB
#undef PG8_STAGE
#undef PG8_LDA
#undef PG8_LDB
#undef PG8_MMA
#undef PG8_WAIT_V
#undef PG8_WAIT_L
#undef PG8_BAR
#undef PG8_SCHED
}

struct DenseSched {
    int nM, nN, nwg, G, c; const char* A; const char* B; size_t tA, tB;
    __device__ void init(const void* A_, const void* B_, int M, int N, int K, int G_, int c_) { nM = M / BM; nN = N / BM; nwg = nM * nN; G = G_; c = c_; A = (const char*)A_; B = (const char*)B_; tA = (size_t)BM * K * 2; tB = tA; }
    __device__ bool next(int i, Unit& u) const {
        const long L = (long)i * G + c; if (L >= nwg) return false;
        int wgid = (int)L; { const int q = nwg / NXCD, r = nwg % NXCD, xcd = wgid % NXCD, off = wgid / NXCD; wgid = (xcd < r ? xcd * (q + 1) : r * (q + 1) + (xcd - r) * q) + off; }
        const int nig = WGM * nN, gid = wgid / nig, fm = gid * WGM, gsz = (nM - fm) < WGM ? (nM - fm) : WGM;
        u.pm = fm + ((wgid % nig) % gsz); u.pn = (wgid % nig) / gsz; u.g = 0; return true;
    }
    __device__ __forceinline__ const char* pA(const Unit& u) const { return A + (size_t)u.pm * tA; }
    __device__ __forceinline__ const char* pB(const Unit& u) const { return B + (size_t)u.pn * tB; }
    __device__ __forceinline__ int ntiles(const Unit&, int full) const { return full; }
};
struct SwapSched {
    int nM, nwg, G, c, dil; const char* W; const char* X;
    __device__ bool next(int i, Unit& u) const { const int L = i * G + c; if (L >= nwg) return false; u.pm = L % nM; u.pn = L / nM; u.g = 0; return true; }
    __device__ __forceinline__ const char* pA(const Unit& u) const { return W + (size_t)u.pm * (256 * DM * 2); }
    __device__ __forceinline__ const char* pB(const Unit& u) const {
        const int b = u.pn >> 4, o = (u.pn & 15) * 256, Ls = SEQ / dil, cc = o / Ls, m0 = o % Ls;
        return X + (size_t)(b * SEQ + m0 * dil + cc) * (DM * 2);
    }
    __device__ __forceinline__ int ntiles(const Unit&, int full) const { return full; }
};
struct GroupSched {
    int nM, nN, nwg, G, c; const char* A; const char* B; size_t gA, tA, gB, tB; int toep;
    __device__ bool next(int i, Unit& u) const { const int L = i * G + c; if (L >= nwg) return false; const int per = nM * nN; u.g = L / per; const int r = L % per; u.pm = r % nM; u.pn = r / nM; return true; }
    __device__ __forceinline__ const char* pA(const Unit& u) const { return A + (size_t)u.g * gA + (size_t)u.pm * tA; }
    __device__ __forceinline__ const char* pB(const Unit& u) const { return B + (size_t)u.g * gB + (size_t)u.pn * tB; }
    __device__ __forceinline__ int ntiles(const Unit& u, int full) const { return (toep && u.pn < 4) ? 4 * u.pn + 4 : full; }
};
}
using pg8::Unit;

constexpr size_t MiB = 1u << 20;
constexpr size_t WS_CTL = 0, CTL_ZERO_BYTES = 1 * MiB;
constexpr size_t WS_WIN  = 1 * MiB;
constexpr size_t WS_WGLU = WS_WIN + (size_t)NCOLS_IN * DM * 2;
constexpr size_t WS_WPA  = WS_WGLU + 768 * 768 * 2;
constexpr size_t WS_WPB  = WS_WPA + 2048 * 512 * 2;
constexpr size_t WS_WPC  = WS_WPB + 2048 * 768 * 2;
constexpr size_t WS_WO   = WS_WPC + 2048 * 768 * 2;
constexpr size_t WS_WFF1 = WS_WO + (size_t)DM * DM * 2;
constexpr size_t WS_WFF2 = WS_WFF1 + (size_t)2 * DFF * DM * 2;
constexpr size_t WS_MISC = WS_WFF2 + (size_t)DM * DFF * 2;
constexpr size_t MS_BIASR = 0;
constexpr size_t MS_WTRIL = 64 * 1024;
constexpr size_t MS_END   = MS_WTRIL + 6 * 128 * 128 * 2;
constexpr size_t WS_S5BT = ((WS_MISC + MS_END + MiB - 1) / MiB) * MiB;
constexpr size_t WS_S5QM = WS_S5BT + (size_t)(48 * 1152 + 128) * 1024 * 2;
constexpr size_t WS_XB   = ((WS_S5QM + (size_t)48 * 1024 * 256 * 2 + MiB - 1) / MiB) * MiB;
constexpr size_t WS_Q    = WS_XB + (size_t)MTOK * DM * 2;
constexpr size_t WS_K    = WS_Q + (size_t)MTOK * 1536 * 2;
constexpr size_t WS_MERGED = WS_Q;
constexpr size_t WS_VT   = WS_K + (size_t)MTOK * 1536 * 2;
constexpr size_t WS_VGT  = WS_VT + (size_t)1536 * MTOK * 2;
constexpr size_t WS_U    = WS_VGT + (size_t)768 * MTOK * 2;
constexpr size_t WS_UC   = WS_U + (size_t)MTOK * 768 * 2;
constexpr size_t WS_GATES = WS_UC + (size_t)MTOK * 768 * 2;
constexpr size_t WS_H    = WS_GATES;
constexpr size_t WS_LSE  = WS_GATES + (size_t)MTOK * 6144 * 2;
constexpr size_t WS_YA   = WS_LSE + (size_t)MTOK * 24 * 4;
constexpr size_t WS_YB   = WS_YA + (size_t)MTOK * 512 * 2;
constexpr size_t WS_YC   = WS_YB + (size_t)MTOK * 768 * 2;
constexpr size_t WS_YC2  = WS_YC + (size_t)MTOK * 768 * 2;
constexpr size_t WS_YI   = WS_YC2 + (size_t)MTOK * 768 * 2;
constexpr size_t WS_E    = WS_YI + (size_t)MTOK * 768 * 2;
constexpr size_t WS_XIN  = WS_E + (size_t)512 * 48 * 128 * 4;
constexpr size_t WS_TAB  = WS_XIN + (size_t)48 * 512 * 256 * 2;
constexpr size_t TAB_PW = 0, TAB_BB = 48 * 64 * 65 * 8, TAB_KJ = TAB_BB + 48 * 64 * 16 * 8, TAB_LAYER = TAB_KJ + 48 * 64 * 256 * 4;
constexpr size_t WS_STAT = WS_TAB + DEPTH * TAB_LAYER;
constexpr size_t WS_END  = WS_STAT + (size_t)MTOK * 8;
static_assert(WS_H + (size_t)MTOK * DFF * 2 <= WS_LSE, "h overlay fits in the gates");
static_assert(WS_MERGED + (size_t)MTOK * DM * 2 <= WS_VT, "merged overlay fits in q|k");

constexpr int CW_TMO = 0, CW_BAR = 4096;
constexpr int RING_OFF = 0, RING_BYTES = 131072, LDSCTL_OFF = RING_BYTES, MISC_OFF = LDSCTL_OFF + 320, LDS_BYTES = 147456;
constexpr int NWAVES = 8;

#define XB_TMO      128
#define XB_XCNT(j)  (256  + 64 * (j))
#define XB_XSUB(j)  (1280 + 64 * (j))
#define XB_XGEN(j)  (2304 + 64 * (j))
#define XB_TOP      3328
#define XB_TOPGEN   3392
#define XCD_BAR_WORDS 3456
#define XB_SPIN_CAP (1u << 18)
__device__ __forceinline__ unsigned xb_ld(unsigned* p)              { return __hip_atomic_load(p, __ATOMIC_RELAXED, __HIP_MEMORY_SCOPE_AGENT); }
__device__ __forceinline__ unsigned xb_add(unsigned* p, unsigned v) { return __hip_atomic_fetch_add(p, v, __ATOMIC_RELAXED, __HIP_MEMORY_SCOPE_AGENT); }
__device__ __forceinline__ unsigned xb_xcc_id() { return (unsigned)__builtin_amdgcn_s_getreg((3 << 11) | 20) & 0xFu; }
#define XB_SPIN(cond, bar) do { unsigned _sp = 0; while (cond) { __builtin_amdgcn_s_sleep(1); \
    if ((++_sp & 255u) == 0u) { if (xb_ld(&(bar)[XB_TMO])) break; if (_sp > XB_SPIN_CAP) { atomicAdd(&(bar)[XB_TMO], 1u); break; } } } } while (0)
struct XcdBarrier { unsigned* bar; unsigned x; volatile LAS unsigned* st; };
__device__ __forceinline__ XcdBarrier xcd_barrier_post(unsigned* bar, volatile LAS unsigned* st) {
    XcdBarrier b; b.bar = bar; b.x = xb_xcc_id(); b.st = st;
    if (threadIdx.x == 0) (void)xb_add(&bar[XB_XCNT(b.x)], 1u);
    return b;
}
__device__ __forceinline__ void xcd_barrier_complete(unsigned* bar, unsigned x, unsigned& nloc, unsigned& nx) {
    const unsigned G = gridDim.x * gridDim.y * gridDim.z;
    unsigned sum, cnt, mine, sp = 0u;
    for (;;) {
        sum = 0u; cnt = 0u; mine = 0u;
#pragma unroll
        for (unsigned j = 0; j < 16; ++j) { const unsigned c = xb_ld(&bar[XB_XCNT(j)]); sum += c; cnt += (c > 0u) ? 1u : 0u; mine = (j == x) ? c : mine; }
        if (sum == G) break;
        __builtin_amdgcn_s_sleep(1);
        if ((++sp & 255u) == 0u) { if (xb_ld(&bar[XB_TMO])) break; if (sp > XB_SPIN_CAP) { atomicAdd(&bar[XB_TMO], 1u); break; } }
    }
    nloc = mine > 0u ? mine : 1u; nx = cnt > 0u ? cnt : 1u;
}
__device__ __forceinline__ void xcd_barrier(const XcdBarrier& b, const bool leader  ) {
    asm volatile("s_waitcnt vmcnt(0)" ::: "memory");
    __syncthreads();
    if (leader) {
        unsigned* bar = b.bar;
        __builtin_amdgcn_s_waitcnt(0);
        unsigned nloc = b.st[0], nx = b.st[1];
        if (nloc == 0u) { xcd_barrier_complete(bar, b.x, nloc, nx); b.st[0] = nloc; b.st[1] = nx; }
        const unsigned old = xb_add(&bar[XB_XSUB(b.x)], 1u);
        const unsigned gen = old / nloc;
        if (old + 1u == (gen + 1u) * nloc) {
            __builtin_amdgcn_fence(__ATOMIC_RELEASE, "agent");
            asm volatile("s_waitcnt vmcnt(0)" ::: "memory");
            const unsigned og = xb_add(&bar[XB_TOP], 1u);
            const unsigned tg = og / nx;
            if (og + 1u == (tg + 1u) * nx) xb_add(&bar[XB_TOPGEN], 1u);
            else XB_SPIN(xb_ld(&bar[XB_TOPGEN]) == tg, bar);
            __builtin_amdgcn_fence(__ATOMIC_ACQUIRE, "agent");
            xb_add(&bar[XB_XGEN(b.x)], 1u);
            asm volatile("s_waitcnt vmcnt(0)" ::: "memory");
        } else {
            XB_SPIN(xb_ld(&bar[XB_XGEN(b.x)]) == gen, bar);
            __builtin_amdgcn_fence(__ATOMIC_ACQUIRE, "agent");
            asm volatile("s_waitcnt vmcnt(0)" ::: "memory");
        }
    }
    __syncthreads();
}

struct Args {
    const float* in[28];
    float* out; unsigned char* ws;
    int ph_lo, ph_hi;
};
enum { I_X = 0, I_WIN, I_BIN, I_REL, I_SLNG, I_SLNB, I_WS, I_BS, I_LRE, I_LIM, I_LDT, I_BRE, I_BIM, I_CRE, I_CIM, I_DSK, I_WGLU, I_BGLU, I_WPA, I_WPB, I_WPC, I_WO,
       I_LN1G, I_LN1B, I_WFF1, I_WFF2, I_LN2G, I_LN2B };

typedef const __attribute__((address_space(4))) unsigned char* kptr_t;
#define KIN(kp, i)  ((const float*)(const GAS float*)(*(const float* const __attribute__((address_space(4)))*)((kp) + 8 * (i))))
#define KOUT(kp)    ((float*)(GAS float*)(*(float* const __attribute__((address_space(4)))*)((kp) + 224)))
#define KWS(kp)     ((unsigned char*)(GAS unsigned char*)(*(unsigned char* const __attribute__((address_space(4)))*)((kp) + 232)))
static_assert(sizeof(Args) == 248, "Args layout");

#define EPI_ROWS_BEGIN  _Pragma("unroll") for (int ai = 0; ai < 2; ++ai) _Pragma("unroll") for (int m = 0; m < 4; ++m) { const int rl = ai * 128 + wr * 64 + m * 16 + fr;
#define EPI_ROWS_END    asm volatile("" ::: "memory"); }
#define EPI_LOADV(v, ai, bj, m) float v[8]; { const f32x4 a0 = acc[ai][bj][m][0], a1 = acc[ai][bj][m][1]; v[0] = a0[0]; v[1] = a0[1]; v[2] = a0[2]; v[3] = a0[3]; v[4] = a1[0]; v[5] = a1[1]; v[6] = a1[2]; v[7] = a1[3]; }

struct EpiInProj {
    static constexpr bool PERM = true;
    bf16_t *Q, *Kb, *U, *UC, *G; const float* bias;
    template <int MODE> __device__ __forceinline__ void run(const f32x4 (&acc)[2][2][4][2], bf16_t* base, int ld, int row0, int colt, int bcol0, int wr, int wc, int fr, int fq) const {
        f32x4 bv[2][2];
#pragma unroll
        for (int bj = 0; bj < 2; ++bj)
#pragma unroll
            for (int n = 0; n < 2; ++n) bv[bj][n] = *(const f32x4*)(bias + bcol0 + bj * 128 + 4 * n);
        EPI_ROWS_BEGIN
            bf16_t* rowp = base + (size_t)(row0 + rl) * ld + colt + wc * 32 + 8 * fq;
#pragma unroll
            for (int bj = 0; bj < 2; ++bj) { EPI_LOADV(v, ai, bj, m)
#pragma unroll
                for (int j = 0; j < 8; ++j) { float x = v[j] + bv[bj][j >> 2][j & 3];
                    if (MODE == 0) x *= 0.125f * LOG2E; else if (MODE == 2) x = gelu_tanh(x); else if (MODE == 3) x = fast_sigmoid(x);
                    v[j] = x; }
                *(u32x4*)(rowp + bj * 128) = pack8(v); }
        EPI_ROWS_END
    }
    __device__ __forceinline__ void operator()(const f32x4 (&acc)[2][2][4][2], const Unit& u, int wr, int wc, int fr, int fq) const {
        const int pn = u.pn, row0 = u.pm * 256, bcol0 = pn * 256 + wc * 32 + 8 * fq;
        if (pn < 6) run<0>(acc, Q, 1536, row0, pn * 256, bcol0, wr, wc, fr, fq);
        else if (pn < 12) run<1>(acc, Kb, 1536, row0, (pn - 6) * 256, bcol0, wr, wc, fr, fq);
        else if (pn < 15) run<2>(acc, U, 768, row0, (pn - 12) * 256, bcol0, wr, wc, fr, fq);
        else if (pn < 18) {
            f32x4 bv[2][2];
#pragma unroll
            for (int bj = 0; bj < 2; ++bj)
#pragma unroll
                for (int n = 0; n < 2; ++n) bv[bj][n] = *(const f32x4*)(bias + bcol0 + bj * 128 + 4 * n);
            EPI_ROWS_BEGIN
#pragma unroll
                for (int bj = 0; bj < 2; ++bj) { EPI_LOADV(v, ai, bj, m)
#pragma unroll
                    for (int j = 0; j < 8; ++j) v[j] += bv[bj][j >> 2][j & 3];
                    const int cc = (pn - 15) * 256 + bj * 128 + wc * 32 + 8 * fq;
                    *(u32x4*)(UC + ((size_t)(cc >> 4) * MTOK + row0 + rl) * 16 + (cc & 15)) = pack8(v); }
            EPI_ROWS_END
        }
        else run<3>(acc, G, 6144, row0, (pn - 18) * 256, bcol0, wr, wc, fr, fq);
    }
};
struct EpiSwap {
    static constexpr bool PERM = true;
    bf16_t *VT, *VGT; const float* bias; int nvt;
    __device__ __forceinline__ void operator()(const f32x4 (&acc)[2][2][4][2], const Unit& u, int wr, int wc, int fr, int fq) const {
        const bool isv = u.pm < nvt;
        bf16_t* base = isv ? VT + (size_t)u.pm * 256 * MTOK : VGT + (size_t)(u.pm - nvt) * 256 * MTOK;
        const int col0 = u.pn * 256 + wc * 32 + 8 * fq;
        EPI_ROWS_BEGIN
            const float bs = bias[u.pm * 256 + rl];
            bf16_t* rowp = base + (size_t)rl * MTOK + col0;
#pragma unroll
            for (int bj = 0; bj < 2; ++bj) { EPI_LOADV(v, ai, bj, m)
#pragma unroll
                for (int j = 0; j < 8; ++j) { const float x = v[j] + bs; v[j] = isv ? x : gelu_tanh(x); }
                *(u32x4*)(rowp + bj * 128) = pack8(v); }
        EPI_ROWS_END
    }
};
struct EpiS5A {
    static constexpr bool PERM = true;
    bf16_t* YI; float* E;
    __device__ __forceinline__ void operator()(const f32x4 (&acc)[2][2][4][2], const Unit& u, int wr, int wc, int fr, int fq) const {
        const int n0 = u.pm * 256, g = u.g;
        if (u.pn < 4) {
            EPI_ROWS_BEGIN
#pragma unroll
                for (int bj = 0; bj < 2; ++bj) { EPI_LOADV(v, ai, bj, m)
                    const int col = u.pn * 256 + bj * 128 + wc * 32 + 8 * fq;
                    *(u32x4*)(YI + (size_t)g * MTOK * 16 + (size_t)(n0 + rl) * 1024 + col) = pack8(v); }
            EPI_ROWS_END
        } else {
            EPI_ROWS_BEGIN
                { const int col = wc * 32 + 8 * fq; float* p = E + ((size_t)(n0 + rl) * 48 + g) * 128 + col;
                  *(f32x4*)p = acc[ai][0][m][0]; *(f32x4*)(p + 4) = acc[ai][0][m][1]; }
            EPI_ROWS_END
        }
    }
};
struct EpiS5B {
    static constexpr bool PERM = true;
    const bf16_t* YI; const bf16_t* UC; const float* dsk; bf16_t* YC;
    __device__ __forceinline__ void operator()(const f32x4 (&acc)[2][2][4][2], const Unit& u, int wr, int wc, int fr, int fq) const {
        const int n0 = u.pm * 256, g = u.g;
        EPI_ROWS_BEGIN
#pragma unroll
            for (int bj = 0; bj < 2; ++bj) { EPI_LOADV(v, ai, bj, m)
                const int col = u.pn * 256 + bj * 128 + wc * 32 + 8 * fq, h0 = col & 15;
                const size_t off = (size_t)g * MTOK * 16 + (size_t)(n0 + rl) * 1024 + col;
                float yi[8], uu[8]; unpack8(*(const u32x4*)(YI + off), yi); unpack8(*(const u32x4*)(UC + off), uu);
                const f32x4 d0 = *(const f32x4*)(dsk + g * 16 + h0), d1 = *(const f32x4*)(dsk + g * 16 + h0 + 4);
#pragma unroll
                for (int j = 0; j < 8; ++j) v[j] = gelu_tanh(v[j] + yi[j] + (j < 4 ? d0[j & 3] : d1[j & 3]) * uu[j]);
                *(u32x4*)(YC + off) = pack8(v); }
        EPI_ROWS_END
    }
};
struct EpiGlu {
    static constexpr bool PERM = true;
    const bf16_t* YC; const float* bias; bf16_t* YC2;
    __device__ __forceinline__ void operator()(const f32x4 (&acc)[2][2][4][2], const Unit& u, int wr, int wc, int fr, int fq) const {
        const int col0 = u.pn * 256 + wc * 32 + 8 * fq;
        EPI_ROWS_BEGIN
#pragma unroll
            for (int bj = 0; bj < 2; ++bj) { EPI_LOADV(v, ai, bj, m)
                const int col = col0 + bj * 128; const size_t off = (size_t)(u.pm * 256 + rl) * 768 + col;
                float y[8]; unpack8(*(const u32x4*)(YC + ((size_t)(col >> 4) * MTOK + (size_t)(u.pm * 256 + rl)) * 16 + (col & 15)), y);
                const f32x4 b0 = *(const f32x4*)(bias + col), b1 = *(const f32x4*)(bias + col + 4);
#pragma unroll
                for (int j = 0; j < 8; ++j) v[j] = y[j] * fast_sigmoid(v[j] + (j < 4 ? b0[j & 3] : b1[j & 3]));
                *(u32x4*)(YC2 + off) = pack8(v); }
        EPI_ROWS_END
    }
};
template <bool ACCUM> struct EpiMerge {
    static constexpr bool PERM = true;
    const bf16_t* G; bf16_t* O;
    __device__ __forceinline__ void operator()(const f32x4 (&acc)[2][2][4][2], const Unit& u, int wr, int wc, int fr, int fq) const {
        const int col0 = u.pn * 256 + wc * 32 + 8 * fq;
        EPI_ROWS_BEGIN
#pragma unroll
            for (int bj = 0; bj < 2; ++bj) { EPI_LOADV(v, ai, bj, m)
                const int col = col0 + bj * 128; const size_t r = (size_t)(u.pm * 256 + rl);
                float gt[8]; unpack8(*(const u32x4*)(G + r * 6144 + col), gt);
                bf16_t* op = O + r * 2048 + col;
                if (ACCUM) { float pv[8]; unpack8(*(const u32x4*)op, pv);
#pragma unroll
                    for (int j = 0; j < 8; ++j) v[j] = pv[j] + gt[j] * v[j]; }
                else {
#pragma unroll
                    for (int j = 0; j < 8; ++j) v[j] = gt[j] * v[j]; }
                *(u32x4*)op = pack8(v); }
        EPI_ROWS_END
    }
};
template <bool LN> struct EpiResid {
    static constexpr bool PERM = false;
    const float* xres; float* out; const f32x2* stat; const float* lng; const float* lnb;
    __device__ __forceinline__ void operator()(const f32x4 (&acc)[2][2][4][2], const Unit& u, int wr, int wc, int fr, int fq) const {
        const int col0 = u.pn * 256 + wc * 32 + 4 * fq;
        f32x4 gv[2][2], bv[2][2];
        if (LN) {
#pragma unroll
            for (int bj = 0; bj < 2; ++bj)
#pragma unroll
                for (int n = 0; n < 2; ++n) { gv[bj][n] = *(const f32x4*)(lng + col0 + bj * 128 + n * 16); bv[bj][n] = *(const f32x4*)(lnb + col0 + bj * 128 + n * 16); }
        }
        EPI_ROWS_BEGIN
            const size_t row = (size_t)(u.pm * 256 + rl), off = row * DM + col0;
            f32x2 st = {0.f, 1.f}; if (LN) st = stat[row];
#pragma unroll
            for (int bj = 0; bj < 2; ++bj)
#pragma unroll
                for (int n = 0; n < 2; ++n) { f32x4 xr = *(const f32x4*)(xres + off + bj * 128 + n * 16);
                    if (LN) xr = (xr - st.x) * st.y * gv[bj][n] + bv[bj][n];
                    *(f32x4*)(out + off + bj * 128 + n * 16) = xr * ALPHA + acc[ai][bj][m][n]; }
        EPI_ROWS_END
    }
};
struct EpiSwiglu {
    static constexpr bool PERM = true;
    bf16_t* H;
    __device__ __forceinline__ void operator()(const f32x4 (&acc)[2][2][4][2], const Unit& u, int wr, int wc, int fr, int fq) const {
        const int col0 = u.pn * 128 + wc * 32 + 8 * fq;
        EPI_ROWS_BEGIN
            { EPI_LOADV(gv, ai, 0, m) EPI_LOADV(uv, ai, 1, m)
#pragma unroll
              for (int j = 0; j < 8; ++j) gv[j] = silu(gv[j]) * uv[j];
              *(u32x4*)(H + (size_t)(u.pm * 256 + rl) * DFF + col0) = pack8(gv); }
        EPI_ROWS_END
    }
};

struct Frame {
    LAS unsigned char* lds;
    int tid, lane, wave, vcu, G;
};

__device__ __forceinline__ void transpose_item(const float* W, int K, int N, bf16_t* WT, int k0, int n0s, int n0d, LAS float* scr, int lane) {
    float wv[32];
#pragma unroll
    for (int i = 0; i < 32; ++i) wv[i] = W[(size_t)(k0 + 2 * i + (lane >> 5)) * N + n0s + (lane & 31)];
#pragma unroll
    for (int i = 0; i < 32; ++i) scr[(2 * i + (lane >> 5)) * 33 + (lane & 31)] = wv[i];
    asm volatile("s_waitcnt lgkmcnt(0)" ::: "memory");
    const int c = lane & 7;
#pragma unroll
    for (int j = 0; j < 4; ++j) { const int n = (lane >> 3) + 8 * j; const LAS float* s = scr + (8 * c) * 33 + n;
        u32x4 o; o.x = cvt_pk_bf16(s[0 * 33], s[1 * 33]); o.y = cvt_pk_bf16(s[2 * 33], s[3 * 33]); o.z = cvt_pk_bf16(s[4 * 33], s[5 * 33]); o.w = cvt_pk_bf16(s[6 * 33], s[7 * 33]);
        *(u32x4*)(WT + (size_t)(n0d + n) * K + k0 + 8 * c) = o; }
    asm volatile("s_waitcnt lgkmcnt(0)" ::: "memory");
}
__device__ __forceinline__ int inproj_src_col(int d) {
    if (d < 3072) return d;
    if (d < 3840) return 4608 + (d - 3072);
    if (d < 4608) return 6144 + (d - 3840);
    if (d < 10752) return 6912 + (d - 4608);
    if (d < 11264) return 3072 + (d - 10752);
    if (d < 12032) return 5376 + (d - 11264);
    return 3072 + 512 + (d - 12032);
}
__device__ __forceinline__ int ff1_src_col(int d) { const int pn = d >> 8, w = d & 255; return (w < 128) ? (128 * pn + w) : (DFF + 128 * pn + (w - 128)); }

__device__ __forceinline__ void phase_convert(const Frame& F, kptr_t kp, int l) {
    unsigned char* ws = KWS(kp);
    LAS float* scr = (LAS float*)(F.lds + RING_OFF + F.wave * 16384);
    const int gw = F.vcu * NWAVES + F.wave, NGW = F.G * NWAVES;
    constexpr int I_IN = (DM / 64) * (NCOLS_IN / 32), I_GLU = (768 / 64) * (768 / 32), I_PA = (512 / 64) * (DM / 32), I_PB = (768 / 64) * (DM / 32), I_O = (DM / 64) * (DM / 32),
                  I_F1 = (DM / 64) * (2 * DFF / 32), I_F2 = (DFF / 64) * (DM / 32);
    constexpr int NITEMS = I_IN + I_GLU + I_PA + 2 * I_PB + I_O + I_F1 + I_F2;
    for (int it = gw; it < NITEMS; it += NGW) {
        int r = it;
        if (r < I_IN) { const int nb = NCOLS_IN / 32, kb = r / nb, n0d = (r % nb) * 32; transpose_item(KIN(kp, I_WIN) + (size_t)l * DM * NCOLS_IN, DM, NCOLS_IN, (bf16_t*)(ws + WS_WIN), kb * 64, inproj_src_col(n0d), n0d, scr, F.lane); continue; } r -= I_IN;
        if (r < I_GLU) { const int nb = 768 / 32, kb = r / nb, n0 = (r % nb) * 32; transpose_item(KIN(kp, I_WGLU) + (size_t)l * 768 * 768, 768, 768, (bf16_t*)(ws + WS_WGLU), kb * 64, n0, n0, scr, F.lane); continue; } r -= I_GLU;
        if (r < I_PA) { const int nb = DM / 32, kb = r / nb, n0 = (r % nb) * 32; transpose_item(KIN(kp, I_WPA) + (size_t)l * 512 * DM, 512, DM, (bf16_t*)(ws + WS_WPA), kb * 64, n0, n0, scr, F.lane); continue; } r -= I_PA;
        if (r < I_PB) { const int nb = DM / 32, kb = r / nb, n0 = (r % nb) * 32; transpose_item(KIN(kp, I_WPB) + (size_t)l * 768 * DM, 768, DM, (bf16_t*)(ws + WS_WPB), kb * 64, n0, n0, scr, F.lane); continue; } r -= I_PB;
        if (r < I_PB) { const int nb = DM / 32, kb = r / nb, n0 = (r % nb) * 32; transpose_item(KIN(kp, I_WPC) + (size_t)l * 768 * DM, 768, DM, (bf16_t*)(ws + WS_WPC), kb * 64, n0, n0, scr, F.lane); continue; } r -= I_PB;
        if (r < I_O) { const int nb = DM / 32, kb = r / nb, n0 = (r % nb) * 32; transpose_item(KIN(kp, I_WO) + (size_t)l * DM * DM, DM, DM, (bf16_t*)(ws + WS_WO), kb * 64, n0, n0, scr, F.lane); continue; } r -= I_O;
        if (r < I_F1) { const int nb = 2 * DFF / 32, kb = r / nb, n0d = (r % nb) * 32; transpose_item(KIN(kp, I_WFF1) + (size_t)l * DM * 2 * DFF, DM, 2 * DFF, (bf16_t*)(ws + WS_WFF1), kb * 64, ff1_src_col(n0d), n0d, scr, F.lane); continue; } r -= I_F1;
        { const int nb = DM / 32, kb = r / nb, n0 = (r % nb) * 32; transpose_item(KIN(kp, I_WFF2) + (size_t)l * DFF * DM, DFF, DM, (bf16_t*)(ws + WS_WFF2), kb * 64, n0, n0, scr, F.lane); }
    }
    const int gt = F.vcu * 512 + F.tid, NGT = F.G * 512;
    if (l == 0) {
        const f32x4* x4 = (const f32x4*)KIN(kp, I_X); u32x2* o = (u32x2*)(ws + WS_XB);
        for (size_t i = gt; i < (size_t)MTOK * DM / 4; i += (size_t)NGT * 8) {
            f32x4 v[8];
#pragma unroll
            for (int j = 0; j < 8; ++j) v[j] = x4[i + (size_t)j * NGT];
#pragma unroll
            for (int j = 0; j < 8; ++j) { u32x2 w; w.x = cvt_pk_bf16(v[j][0], v[j][1]); w.y = cvt_pk_bf16(v[j][2], v[j][3]); o[i + (size_t)j * NGT] = w; } }
    }
    { float* br = (float*)(ws + WS_MISC + MS_BIASR); const float* b = KIN(kp, I_BIN) + (size_t)l * NCOLS_IN;
      for (int i = gt; i < NCOLS_IN; i += NGT) br[i] = b[inproj_src_col(i)]; }
    { bf16_t* wt = (bf16_t*)(ws + WS_MISC + MS_WTRIL); const float* w = KIN(kp, I_WS) + (size_t)l * 6 * 128 * 128;
      for (int i = gt; i < 6 * 128 * 128 / 2; i += NGT) { const int e = 2 * i, t = (e >> 7) & 127, s = e & 127; const float w0 = (s <= t) ? w[e] : 0.f, w1 = (s + 1 <= t) ? w[e + 1] : 0.f; ((unsigned*)wt)[i] = cvt_pk_bf16(w0, w1); } }
}
__device__ __forceinline__ void phase_tables(const Frame& F, kptr_t kp) {
    unsigned char* ws = KWS(kp);
    const int gt0 = F.vcu * 512 + F.tid;
    if (gt0 < DEPTH * 48 * 64) {
        const int l = gt0 / 3072, gt = gt0 % 3072;
        const int g = gt >> 6;
        const double dt = exp((double)KIN(kp, I_LDT)[l * 48 + g]);
        const double lr = (double)KIN(kp, I_LRE)[(size_t)l * 3072 + gt], li = (double)KIN(kp, I_LIM)[(size_t)l * 3072 + gt];
        const double mag = exp(lr * dt), ang = li * dt;
        const double abr = mag * cos(ang), abi = mag * sin(ang);
        const double nrm = lr * lr + li * li;
        const double cr = ((abr - 1.0) * lr + abi * li) / nrm, ci = (abi * lr - (abr - 1.0) * li) / nrm;
        f32x2* BB = (f32x2*)(ws + WS_TAB + (size_t)l * TAB_LAYER + TAB_BB) + (size_t)gt * 16;
        const float* bre = KIN(kp, I_BRE) + ((size_t)l * 3072 + gt) * 16; const float* bim = KIN(kp, I_BIM) + ((size_t)l * 3072 + gt) * 16;
        for (int h = 0; h < 16; ++h) { const double br_ = bre[h], bi_ = bim[h]; BB[h] = (f32x2){(float)(cr * br_ - ci * bi_), (float)(cr * bi_ + ci * br_)}; }
        f32x2* PW = (f32x2*)(ws + WS_TAB + (size_t)l * TAB_LAYER + TAB_PW) + (size_t)gt * 65;
        double pr = 1.0, pi = 0.0;
        for (int j = 0; j <= 64; ++j) { PW[j] = (f32x2){(float)pr, (float)pi}; const double nr = pr * abr - pi * abi, ni = pr * abi + pi * abr; pr = nr; pi = ni; }
    }
}
__device__ __forceinline__ void phase_kj(const Frame& F, kptr_t kp) {
    unsigned char* ws = KWS(kp);
    const int gt = F.vcu * 512 + F.tid, NGT = F.G * 512;
    for (int i = gt; i < DEPTH * 48 * 16 * 64; i += NGT) {
        const int j = i & 63, hp = (i >> 6) & 15, g = (i >> 10) % 48, l = (i >> 10) / 48;
        const f32x2* PW = (const f32x2*)(ws + WS_TAB + (size_t)l * TAB_LAYER + TAB_PW); const f32x2* BB = (const f32x2*)(ws + WS_TAB + (size_t)l * TAB_LAYER + TAB_BB);
        const float* cre = KIN(kp, I_CRE) + ((size_t)l * 48 + g) * 16 * 64 + hp * 64; const float* cim = KIN(kp, I_CIM) + ((size_t)l * 48 + g) * 16 * 64 + hp * 64;
        float acc[16];
#pragma unroll
        for (int h = 0; h < 16; ++h) acc[h] = 0.f;
        for (int p = 0; p < 64; ++p) {
            const float c_r = cre[p], c_i = cim[p]; const f32x2 pw = PW[(size_t)(g * 64 + p) * 65 + j];
            const float wr_ = c_r * pw.x - c_i * pw.y, wi_ = c_r * pw.y + c_i * pw.x;
            const f32x4* bb = (const f32x4*)(BB + (size_t)(g * 64 + p) * 16);
#pragma unroll
            for (int h2 = 0; h2 < 8; ++h2) { const f32x4 b = bb[h2]; acc[2 * h2] += wr_ * b[0] - wi_ * b[1]; acc[2 * h2 + 1] += wr_ * b[2] - wi_ * b[3]; }
        }
        f32x4* o = (f32x4*)((float*)(ws + WS_TAB + (size_t)l * TAB_LAYER + TAB_KJ) + (((size_t)g * 64 + j) * 16 + hp) * 16);
#pragma unroll
        for (int h4 = 0; h4 < 4; ++h4) o[h4] = (f32x4){acc[4 * h4], acc[4 * h4 + 1], acc[4 * h4 + 2], acc[4 * h4 + 3]};
    }
}
__device__ __forceinline__ void phase_s5mats(const Frame& F, kptr_t kp, int l) {
    unsigned char* ws = KWS(kp);
    const int gt = F.vcu * 512 + F.tid, NGT = F.G * 512;
    const f32x2* PW = (const f32x2*)(ws + WS_TAB + (size_t)l * TAB_LAYER + TAB_PW); const f32x2* BB = (const f32x2*)(ws + WS_TAB + (size_t)l * TAB_LAYER + TAB_BB);
    const float* KJ = (const float*)(ws + WS_TAB + (size_t)l * TAB_LAYER + TAB_KJ);
    bf16_t* BT = (bf16_t*)(ws + WS_S5BT);
    for (int i = gt; i < 48 * 1152 * 128; i += NGT) {
        const int ch = i & 127, row = (i >> 7) % 1152, g = (i >> 7) / 1152;
        const int k0 = ch * 8, s = k0 >> 4, h0 = k0 & 15;
        float v[8];
        if (row < 1024) {
            const int t = row >> 4, hp = row & 15;
            if (s >= (t & ~15) + 16) continue;
            if (s <= t) { const float* kq = KJ + (((size_t)g * 64 + (t - s)) * 16 + hp) * 16 + h0; const f32x4 k0v = *(const f32x4*)kq, k1v = *(const f32x4*)(kq + 4);
                v[0] = k0v[0]; v[1] = k0v[1]; v[2] = k0v[2]; v[3] = k0v[3]; v[4] = k1v[0]; v[5] = k1v[1]; v[6] = k1v[2]; v[7] = k1v[3]; }
            else {
#pragma unroll
                for (int j = 0; j < 8; ++j) v[j] = 0.f; }
        } else {
            const int r2 = row - 1024, ri = r2 >> 6, p = r2 & 63;
            const f32x2 pw = PW[(size_t)(g * 64 + p) * 65 + (63 - s)];
#pragma unroll
            for (int j = 0; j < 8; ++j) { const f32x2 bb = BB[(size_t)(g * 64 + p) * 16 + h0 + j]; v[j] = ri ? (pw.x * bb.y + pw.y * bb.x) : (pw.x * bb.x - pw.y * bb.y); }
        }
        *(u32x4*)(BT + ((size_t)g * 1152 + row) * 1024 + k0) = pack8(v);
    }
    const float* cre = KIN(kp, I_CRE) + (size_t)l * 48 * 16 * 64; const float* cim = KIN(kp, I_CIM) + (size_t)l * 48 * 16 * 64;
    bf16_t* QM = (bf16_t*)(ws + WS_S5QM);
    for (int i = gt; i < 48 * 1024 * 32; i += NGT) {
        const int ch = i & 31, row = (i >> 5) & 1023, g = i >> 15;
        const int t = row >> 4, hp = row & 15, k0 = ch * 8;
        float v[8];
        if (k0 < 128) {
            const int ri = k0 >> 6, p0 = k0 & 63;
#pragma unroll
            for (int j = 0; j < 8; ++j) { const int p = p0 + j; const float c_r = cre[(g * 16 + hp) * 64 + p], c_i = cim[(g * 16 + hp) * 64 + p]; const f32x2 pw = PW[(size_t)(g * 64 + p) * 65 + t + 1];
                v[j] = ri ? -(c_r * pw.y + c_i * pw.x) : (c_r * pw.x - c_i * pw.y); }
        } else {
#pragma unroll
            for (int j = 0; j < 8; ++j) v[j] = 0.f;
        }
        *(u32x4*)(QM + ((size_t)g * 1024 + row) * 256 + k0) = pack8(v);
    }
}

constexpr int ATT_KROW = 144, ATT_VROW = 776;
constexpr int ATT_K_OFF = 0, ATT_V_OFF = 384 * ATT_KROW, ATT_TAB_OFF = ATT_V_OFF + 64 * ATT_VROW;
static_assert(ATT_TAB_OFF + 24 * 192 * 4 <= RING_BYTES, "attention LDS map");
__device__ __forceinline__ void phase_attention(const Frame& F, kptr_t kp, const bool dry) {
    unsigned char* ws = KWS(kp);
    LAS unsigned char* lk = F.lds + RING_OFF + ATT_K_OFF; LAS unsigned char* lv = F.lds + RING_OFF + ATT_V_OFF;
    LAS float* tab = (LAS float*)(F.lds + RING_OFF + ATT_TAB_OFF);
    const float* rel = KIN(kp, I_REL);
    for (int i = F.tid; i < 24 * 192; i += 512) { const int gh = i / 192, idx = i % 192, steps = idx - 31, g = gh >> 3;
        tab[i] = (steps >= 0 && steps <= 128) ? rel[(int)T5B[g][steps] * 24 + gh] * LOG2E : -1.0e30f; }
    bf16_t* Qb = (bf16_t*)(ws + WS_Q); const bf16_t* Kb = (const bf16_t*)(ws + WS_K); const bf16_t* VT = (const bf16_t*)(ws + WS_VT);
    const int lane = F.lane, q = lane & 31, hh = lane >> 5, w = F.wave;
    u32x4 kr[6], vr[6];
#define ATT_DECODE(u_) const int g = (u_) >> 10, r_ = (u_) & 1023, b = r_ >> 7, r2_ = r_ & 127, h = r2_ >> 4, blk8 = r2_ & 15; \
        const int dil = (g == 0) ? 1 : (g == 1 ? 4 : 16), Ls = SEQ / dil, nb8 = Ls / 256; const int c = blk8 / nb8, M0 = (blk8 % nb8) * 256, gh = g * 8 + h;
#define ATT_FETCH(u_) do { ATT_DECODE(u_) \
        _Pragma("unroll") for (int i = 0; i < 6; ++i) { const int idx = F.tid + 512 * i, row = idx >> 3, ch = idx & 7; int pos = M0 - 128 + row; pos = pos < 0 ? 0 : pos; \
            kr[i] = *(const u32x4*)(Kb + ((size_t)b * SEQ + (size_t)pos * dil + c) * 1536 + gh * 64 + ch * 8); } \
        _Pragma("unroll") for (int i = 0; i < 6; ++i) { const int idx = F.tid + 512 * i, dim = idx / 48, ch = idx % 48; int pos = M0 - 128 + ch * 8; pos = pos < 0 ? 0 : pos; \
            vr[i] = *(const u32x4*)(VT + (size_t)(gh * 64 + dim) * MTOK + (size_t)b * SEQ + (size_t)c * Ls + pos); } } while (0)
    if (F.vcu < 3072) ATT_FETCH(F.vcu);
    for (int u = F.vcu; u < 3072; u += F.G) {
        ATT_DECODE(u)
        const size_t tq = (size_t)b * SEQ + (size_t)(M0 + 32 * w + q) * dil + c;
        bf16_t* qrow = Qb + tq * 1536 + gh * 64;
        bf16x8 qf[4];
#pragma unroll
        for (int s = 0; s < 4; ++s) qf[s] = *(const bf16x8*)(qrow + s * 16 + hh * 8);
#pragma unroll
        for (int i = 0; i < 6; ++i) { const int idx = F.tid + 512 * i, row = idx >> 3, ch = idx & 7; *(LAS u32x4*)(lk + row * ATT_KROW + ch * 16) = kr[i]; }
#pragma unroll
        for (int i = 0; i < 6; ++i) { const int idx = F.tid + 512 * i, dim = idx / 48, ch = idx % 48; LAS unsigned char* d = lv + dim * ATT_VROW + ch * 16;
            *(LAS u32x2*)d = (u32x2){vr[i].x, vr[i].y}; *(LAS u32x2*)(d + 8) = (u32x2){vr[i].z, vr[i].w}; }
        if (u + F.G < 3072) ATT_FETCH(u + F.G);
        __syncthreads();
        const int jmin = (M0 == 0 && w < 4) ? 4 - w : 0;
        const LAS float* tb = tab + gh * 192;
        f32x16 sc[5];
        float mx = -3.0e38f;
#pragma unroll
        for (int j = 0; j < 5; ++j) {
            const LAS unsigned char* krow = lk + (32 * w + 32 * j + q) * ATT_KROW + hh * 16;
            f32x16 acc;
#pragma unroll
            for (int i = 0; i < 16; ++i) acc[i] = 0.f;
#pragma unroll
            for (int s = 0; s < 4; ++s) { const bf16x8 kf = *(const LAS bf16x8*)(krow + s * 32); acc = __builtin_amdgcn_mfma_f32_32x32x16_bf16(kf, qf[s], acc, 0, 0, 0); }
            const float tmask = (j < jmin) ? -1.0e30f : 0.f;
#pragma unroll
            for (int i = 0; i < 16; ++i) { const int ki = (i & 3) + 8 * (i >> 2) + 4 * hh; const float v = acc[i] + tb[159 + q - 32 * j - ki] + tmask; acc[i] = v; mx = fmaxf(mx, v); }
            sc[j] = acc;
        }
        mx = fmaxf(mx, shfl_xor_l(mx, 32, lane));
        float den = 0.f;
        f32x16 o0, o1;
#pragma unroll
        for (int i = 0; i < 16; ++i) { o0[i] = 0.f; o1[i] = 0.f; }
#pragma unroll
        for (int j = 0; j < 5; ++j) {
            float p[16];
#pragma unroll
            for (int i = 0; i < 16; ++i) { p[i] = __builtin_amdgcn_exp2f(sc[j][i] - mx); den += p[i]; }
#pragma unroll
            for (int s = 0; s < 2; ++s) {
                union { bf16x8 v; unsigned w4[4]; } pf;
#pragma unroll
                for (int e = 0; e < 4; ++e) pf.w4[e] = cvt_pk_bf16(p[8 * s + 2 * e], p[8 * s + 2 * e + 1]);
#pragma unroll
                for (int d = 0; d < 2; ++d) {
                    const LAS unsigned char* vrow = lv + (d * 32 + q) * ATT_VROW + (32 * w + 32 * j + 16 * s + 4 * hh) * 2;
                    union { bf16x8 v; u32x2 h2[2]; } vf;
                    vf.h2[0] = *(const LAS u32x2*)vrow; vf.h2[1] = *(const LAS u32x2*)(vrow + 16);
                    if (d == 0) o0 = __builtin_amdgcn_mfma_f32_32x32x16_bf16(vf.v, pf.v, o0, 0, 0, 0);
                    else        o1 = __builtin_amdgcn_mfma_f32_32x32x16_bf16(vf.v, pf.v, o1, 0, 0, 0);
                }
            }
        }
        den += shfl_xor_l(den, 32, lane);
        const float rden = 1.0f / den;
        bf16_t* orow = dry ? (bf16_t*)(ws + WS_YC) + tq * 1536 + gh * 64 : qrow;
#pragma unroll
        for (int d = 0; d < 2; ++d)
#pragma unroll
            for (int gq = 0; gq < 4; ++gq) { const f32x16& o = d ? o1 : o0; u32x2 wv; wv.x = cvt_pk_bf16(o[4 * gq] * rden, o[4 * gq + 1] * rden); wv.y = cvt_pk_bf16(o[4 * gq + 2] * rden, o[4 * gq + 3] * rden);
                *(u32x2*)(orow + d * 32 + 8 * gq + 4 * hh) = wv; }
        if (hh == 0 && !dry) ((float*)(ws + WS_LSE))[tq * 24 + gh] = (mx + __builtin_amdgcn_logf(den)) * LN2;
        __syncthreads();
    }
}

__device__ __forceinline__ void phase_gmlp(const Frame& F, kptr_t kp, int l) {
    unsigned char* ws = KWS(kp);
    LAS float* part = (LAS float*)(F.lds + RING_OFF);
    LAS f32x2* stat = (LAS f32x2*)(F.lds + RING_OFF + 32768);
    const bf16_t* VGT = (const bf16_t*)(ws + WS_VGT); const bf16_t* U = (const bf16_t*)(ws + WS_U); bf16_t* YB = (bf16_t*)(ws + WS_YB);
    const bf16_t* WT = (const bf16_t*)(ws + WS_MISC + MS_WTRIL);
    const float* lng = KIN(kp, I_SLNG) + l * 768; const float* lnb = KIN(kp, I_SLNB) + l * 768; const float* bs = KIN(kp, I_BS) + l * 768;
    const int lane = F.lane, q = lane & 31, hh = lane >> 5;
    for (int ck = F.vcu; ck < MTOK / 128; ck += F.G) {
        const size_t tok0 = (size_t)ck * 128;
        { const int t8 = (F.tid & 15) * 8, pt = F.tid >> 4; float sm[8], sq[8];
#pragma unroll
          for (int j = 0; j < 8; ++j) { sm[j] = 0.f; sq[j] = 0.f; }
#pragma unroll 6
          for (int i = 0; i < 24; ++i) { float v[8]; unpack8(*(const u32x4*)(VGT + (size_t)(pt * 24 + i) * MTOK + tok0 + t8), v);
#pragma unroll
              for (int j = 0; j < 8; ++j) { sm[j] += v[j]; sq[j] += v[j] * v[j]; } }
#pragma unroll
          for (int j = 0; j < 8; ++j) { part[(pt * 128 + t8 + j) * 2] = sm[j]; part[(pt * 128 + t8 + j) * 2 + 1] = sq[j]; } }
        __syncthreads();
        if (F.tid < 128) { float s = 0.f, s2 = 0.f;
#pragma unroll 8
            for (int pt = 0; pt < 32; ++pt) { s += part[(pt * 128 + F.tid) * 2]; s2 += part[(pt * 128 + F.tid) * 2 + 1]; }
            const float mean = s * (1.0f / 768.0f), var = fmaxf(s2 * (1.0f / 768.0f) - mean * mean, 0.f);
            stat[F.tid] = (f32x2){mean, 1.0f / sqrtf(var + LN_EPS)}; }
        __syncthreads();
        const int ct = F.wave & 3, tta = (F.wave >> 2) ? 1 : 0, ttb = (F.wave >> 2) ? 2 : 3;
        for (int g = 0; g < 6; ++g) {
            const int cch = g * 128 + ct * 32 + q;
            const float gg = lng[cch], gb = lnb[cch];
            const bf16_t* vrow = VGT + (size_t)cch * MTOK + tok0;
            const bf16_t* wa = WT + ((size_t)g * 128 + tta * 32 + q) * 128; const bf16_t* wb = WT + ((size_t)g * 128 + ttb * 32 + q) * 128;
            f32x16 ca, cb;
#pragma unroll
            for (int i = 0; i < 16; ++i) { ca[i] = 0.f; cb[i] = 0.f; }
#pragma unroll
            for (int ks = 0; ks < 8; ++ks) {
                const int s0 = 16 * ks + 8 * hh;
                float vv[8]; unpack8(*(const u32x4*)(vrow + s0), vv);
#pragma unroll
                for (int j = 0; j < 8; ++j) { const f32x2 st = stat[s0 + j]; vv[j] = (vv[j] - st.x) * st.y * gg + gb; }
                union { bf16x8 v; u32x4 w; } af; af.w = pack8(vv);
                const bf16x8 bfb = *(const bf16x8*)(wb + s0), bfa = *(const bf16x8*)(wa + s0);
                cb = __builtin_amdgcn_mfma_f32_32x32x16_bf16(af.v, bfb, cb, 0, 0, 0);
                ca = __builtin_amdgcn_mfma_f32_32x32x16_bf16(af.v, bfa, ca, 0, 0, 0);
            }
#pragma unroll
            for (int w2 = 0; w2 < 2; ++w2) {
                const int tt = w2 ? ttb : tta; const f32x16& cc = w2 ? cb : ca;
                const int t = tt * 32 + q; const float bsv = bs[g * 128 + t];
                const size_t rowoff = (tok0 + t) * 768 + g * 128 + ct * 32 + 4 * hh;
#pragma unroll
                for (int gq = 0; gq < 4; ++gq) { const u32x2 uw = *(const u32x2*)(U + rowoff + 8 * gq);
                    u32x2 w; w.x = cvt_pk_bf16(bf_lo(uw.x) * (cc[4 * gq] + bsv), bf_hi(uw.x) * (cc[4 * gq + 1] + bsv)); w.y = cvt_pk_bf16(bf_lo(uw.y) * (cc[4 * gq + 2] + bsv), bf_hi(uw.y) * (cc[4 * gq + 3] + bsv));
                    *(u32x2*)(YB + rowoff + 8 * gq) = w; }
            }
        }
        __syncthreads();
    }
}

__device__ __forceinline__ void phase_carry_combine(const Frame& F, kptr_t kp, int l) {
    unsigned char* ws = KWS(kp);
    const int gt = F.vcu * 512 + F.tid, NGT = F.G * 512;
    const f32x2* PW = (const f32x2*)(ws + WS_TAB + (size_t)l * TAB_LAYER + TAB_PW);
    const float* E = (const float*)(ws + WS_E); bf16_t* XIN = (bf16_t*)(ws + WS_XIN);
    for (int i = gt; i < BATCH * 48 * 64; i += NGT) {
        const int p = i & 63, g = (i >> 6) % 48, b = (i >> 6) / 48;
        const f32x2 aT = PW[(size_t)(g * 64 + p) * 65 + 64];
        float xr = 0.f, xi = 0.f;
        for (int c = 0; c < 64; ++c) {
            const int n = b * 64 + c;
            bf16_t* xo = XIN + ((size_t)g * 512 + n) * 256;
            xo[p] = (bf16_t)(cvt_pk_bf16(xr, 0.f) & 0xffffu); xo[64 + p] = (bf16_t)(cvt_pk_bf16(xi, 0.f) & 0xffffu); xo[128 + p] = 0; xo[192 + p] = 0;
            const float er = E[((size_t)n * 48 + g) * 128 + p], ei = E[((size_t)n * 48 + g) * 128 + 64 + p];
            const float nr = aT.x * xr - aT.y * xi + er, ni = aT.x * xi + aT.y * xr + ei; xr = nr; xi = ni;
        }
    }
    const bf16_t* O = (const bf16_t*)(ws + WS_Q); const float* LSE = (const float*)(ws + WS_LSE); bf16_t* YA = (bf16_t*)(ws + WS_YA);
    for (size_t i = gt; i < (size_t)MTOK * 64; i += NGT) {
        const size_t tok = i >> 6; const int h = (int)(i >> 3) & 7, ch = (int)i & 7;
        const float l0 = LSE[tok * 24 + h], l1 = LSE[tok * 24 + 8 + h], l2 = LSE[tok * 24 + 16 + h];
        const float mx = fmaxf(l0, fmaxf(l1, l2));
        float w0 = __builtin_amdgcn_exp2f((l0 - mx) * LOG2E), w1 = __builtin_amdgcn_exp2f((l1 - mx) * LOG2E), w2 = __builtin_amdgcn_exp2f((l2 - mx) * LOG2E);
        const float rs = 1.0f / (w0 + w1 + w2); w0 *= rs; w1 *= rs; w2 *= rs;
        float o0[8], o1[8], o2[8];
        unpack8(*(const u32x4*)(O + tok * 1536 + h * 64 + ch * 8), o0); unpack8(*(const u32x4*)(O + tok * 1536 + 512 + h * 64 + ch * 8), o1); unpack8(*(const u32x4*)(O + tok * 1536 + 1024 + h * 64 + ch * 8), o2);
#pragma unroll
        for (int j = 0; j < 8; ++j) o0[j] = w0 * o0[j] + w1 * o1[j] + w2 * o2[j];
        *(u32x4*)(YA + tok * 512 + h * 64 + ch * 8) = pack8(o0);
    }
}

__device__ __forceinline__ void phase_ln(const Frame& F, kptr_t kp, const float* gam, const float* bet, bool final_out) {
    const int gw = F.vcu * NWAVES + F.wave, NGW = F.G * NWAVES;
    bf16_t* XB = (bf16_t*)(KWS(kp) + WS_XB); f32x2* STAT = (f32x2*)(KWS(kp) + WS_STAT);
    for (int r = gw; r < MTOK; r += NGW) {
        f32x4* xr = (f32x4*)(KOUT(kp) + (size_t)r * DM) + F.lane;
        f32x4 v[8]; float s = 0.f;
#pragma unroll
        for (int j = 0; j < 8; ++j) { v[j] = xr[64 * j]; s += (v[j][0] + v[j][1]) + (v[j][2] + v[j][3]); }
        const float mean = wave_sum(s, F.lane) * (1.0f / DM); float s2 = 0.f;
#pragma unroll
        for (int j = 0; j < 8; ++j) { v[j] = v[j] - mean; s2 += (v[j][0] * v[j][0] + v[j][1] * v[j][1]) + (v[j][2] * v[j][2] + v[j][3] * v[j][3]); }
        const float rstd = 1.0f / sqrtf(wave_sum(s2, F.lane) * (1.0f / DM) + LN_EPS);
        if (F.lane == 0) STAT[r] = (f32x2){mean, rstd};
        u32x2* ob = (u32x2*)(XB + (size_t)r * DM) + F.lane;
#pragma unroll
        for (int j = 0; j < 8; ++j) { const f32x4 gg = *((const f32x4*)gam + F.lane + 64 * j), bb = *((const f32x4*)bet + F.lane + 64 * j);
            const f32x4 o = v[j] * rstd * gg + bb;
            if (final_out) xr[64 * j] = o;
            else { u32x2 w; w.x = cvt_pk_bf16(o[0], o[1]); w.y = cvt_pk_bf16(o[2], o[3]); ob[64 * j] = w; } }
    }
}

__global__ void __launch_bounds__(NWAVES * 64, 2) mk_fwd(Args args) {
    extern __shared__ __attribute__((aligned(16))) unsigned char lds_raw[];
    LAS unsigned char* const lds = (LAS unsigned char*)lds_raw;
    int wave_s = __builtin_amdgcn_readfirstlane((int)threadIdx.x >> 6); asm volatile("" : "+s"(wave_s));
    for (int u = threadIdx.x; u < (LDS_BYTES - LDSCTL_OFF) / 4; u += NWAVES * 64) ((LAS unsigned*)(lds + LDSCTL_OFF))[u] = 0u;
    __syncthreads();
#if MK_MULTI
#define GRID_BAR() do {} while (0)
#else
    (void)xcd_barrier_post((unsigned*)(args.ws + WS_CTL) + CW_BAR, (volatile LAS unsigned*)(lds + MISC_OFF) + 8);
#define GRID_BAR() do { PH_REFRESH(); unsigned* bp_ = (unsigned*)(ws + WS_CTL) + CW_BAR; asm volatile("" : "+s"(bp_)); XcdBarrier b_; b_.bar = bp_; b_.x = xb_xcc_id(); b_.st = (volatile LAS unsigned*)(lds + MISC_OFF) + 8; xcd_barrier(b_, F.tid == 0); } while (0)
#endif
    const int lo = args.ph_lo, hi = args.ph_hi;
#define IN(k) (lo <= (k) && (k) < hi)
#define SEAM(k) do { if (IN((k) + 1)) GRID_BAR(); } while (0)
    LAS unsigned char* const ring = lds + RING_OFF;

#define PH_BEGIN() kptr_t kp = (kptr_t)__builtin_amdgcn_kernarg_segment_ptr(); asm volatile("" : "+s"(kp)); unsigned char* ws = KWS(kp); \
        int bx = (int)blockIdx.x; asm volatile("" : "+s"(bx)); unsigned wz_ = (unsigned)wave_s << 6; asm volatile("" : "+s"(wz_)); int tid_ = (int)__builtin_amdgcn_mbcnt_hi(~0u, __builtin_amdgcn_mbcnt_lo(~0u, wz_)); int G_ = (int)gridDim.x; asm volatile("" : "+s"(G_)); \
        Frame F; F.lds = lds; F.tid = tid_; F.lane = tid_ & 63; F.wave = wave_s; F.G = G_; F.vcu = (G_ % 8 == 0) ? (bx % 8) * (G_ / 8) + bx / 8 : bx;
#define PH_REFRESH() do { unsigned wz2_ = (unsigned)wave_s << 6; asm volatile("" : "+s"(wz2_)); F.tid = (int)__builtin_amdgcn_mbcnt_hi(~0u, __builtin_amdgcn_mbcnt_lo(~0u, wz2_)); F.lane = F.tid & 63; } while (0)
    if (IN(0)) { PH_BEGIN(); phase_tables(F, kp); SEAM(0); }
    if (IN(1)) { PH_BEGIN(); REP(1) phase_kj(F, kp); SEAM(1); }
    for (int l = 0; l < DEPTH; ++l) {
        const int pb = 2 + l * NPH;
        if (IN(pb + 0)) { PH_BEGIN(); REP(0) phase_convert(F, kp, l); REP(2) phase_s5mats(F, kp, l); SEAM(pb + 0); }
        if (IN(pb + 1)) { PH_BEGIN(); REP(3) {
            const float* biasr = (const float*)(ws + WS_MISC + MS_BIASR);
            { pg8::DenseSched S; S.init(ws + WS_XB, ws + WS_WIN, MTOK, 10752, DM, F.G, bx);
              EpiInProj E{(bf16_t*)(ws + WS_Q), (bf16_t*)(ws + WS_K), (bf16_t*)(ws + WS_U), (bf16_t*)(ws + WS_UC), (bf16_t*)(ws + WS_GATES), biasr};
              pg8::gemm_phase(F.tid, ring, DM, pg8::dense_op(DM), pg8::dense_op(DM), S, E); }
            PH_REFRESH();
            { pg8::SwapSched S; S.nM = 5; S.nwg = 5 * 128; S.G = F.G; S.c = bx; S.dil = 1; S.W = (const char*)(ws + WS_WIN) + (size_t)10752 * DM * 2; S.X = (const char*)(ws + WS_XB);
              EpiSwap E{(bf16_t*)(ws + WS_VT), (bf16_t*)(ws + WS_VGT), biasr + 10752, 2};
              pg8::OpDesc dB = pg8::dense_op(DM);
              pg8::gemm_phase(F.tid, ring, DM, pg8::dense_op(DM), dB, S, E); }
            PH_REFRESH();
            { pg8::SwapSched S; S.nM = 2; S.nwg = 2 * 128; S.G = F.G; S.c = bx; S.dil = 4; S.W = (const char*)(ws + WS_WIN) + (size_t)12032 * DM * 2; S.X = (const char*)(ws + WS_XB);
              EpiSwap E{(bf16_t*)(ws + WS_VT) + (size_t)512 * MTOK, (bf16_t*)(ws + WS_VGT), biasr + 12032, 2};
              pg8::OpDesc dB = pg8::dense_op(DM); dB.rs = 4u * DM * 2u;
              pg8::gemm_phase(F.tid, ring, DM, pg8::dense_op(DM), dB, S, E); }
            PH_REFRESH();
            { pg8::SwapSched S; S.nM = 2; S.nwg = 2 * 128; S.G = F.G; S.c = bx; S.dil = 16; S.W = (const char*)(ws + WS_WIN) + (size_t)12544 * DM * 2; S.X = (const char*)(ws + WS_XB);
              EpiSwap E{(bf16_t*)(ws + WS_VT) + (size_t)1024 * MTOK, (bf16_t*)(ws + WS_VGT), biasr + 12544, 2};
              pg8::OpDesc dB = pg8::dense_op(DM); dB.rs = 16u * DM * 2u;
              pg8::gemm_phase(F.tid, ring, DM, pg8::dense_op(DM), dB, S, E); }
            PH_REFRESH(); }
            SEAM(pb + 1);
        }
        if (IN(pb + 2)) { PH_BEGIN();
            REP(40) { PH_REFRESH(); pg8::GroupSched S; S.nM = 2; S.nN = 5; S.nwg = 480; S.G = F.G; S.c = bx; S.toep = 1;
              S.A = (const char*)(ws + WS_UC); S.gA = (size_t)MTOK * 16 * 2; S.tA = (size_t)256 * 1024 * 2;
              S.B = (const char*)(ws + WS_S5BT); S.gB = (size_t)1152 * 1024 * 2; S.tB = (size_t)256 * 1024 * 2;
              EpiS5A E{(bf16_t*)(ws + WS_YI), (float*)(ws + WS_E)};
              pg8::gemm_phase(F.tid, ring, 1024, pg8::dense_op(1024), pg8::dense_op(1024), S, E); }
            PH_REFRESH();
            REP(41) phase_gmlp(F, kp, l);
            if ((MK_REPEAT) == 42) phase_attention(F, kp, true);
            phase_attention(F, kp, false);
            SEAM(pb + 2);
        }
        if (IN(pb + 3)) { PH_BEGIN(); REP(5) phase_carry_combine(F, kp, l); SEAM(pb + 3); }
        if (IN(pb + 4)) { PH_BEGIN(); REP(6) { PH_REFRESH();
            pg8::GroupSched S; S.nM = 2; S.nN = 4; S.nwg = 384; S.G = F.G; S.c = bx; S.toep = 0;
            S.A = (const char*)(ws + WS_XIN); S.gA = (size_t)512 * 256 * 2; S.tA = (size_t)256 * 256 * 2;
            S.B = (const char*)(ws + WS_S5QM); S.gB = (size_t)1024 * 256 * 2; S.tB = (size_t)256 * 256 * 2;
            EpiS5B E{(const bf16_t*)(ws + WS_YI), (const bf16_t*)(ws + WS_UC), KIN(kp, I_DSK) + l * 768, (bf16_t*)(ws + WS_YC)};
            pg8::gemm_phase(F.tid, ring, 256, pg8::dense_op(256), pg8::dense_op(256), S, E); }
            SEAM(pb + 4);
        }
        if (IN(pb + 5)) { PH_BEGIN(); REP(7) { PH_REFRESH();
            pg8::DenseSched S; S.init(ws + WS_YC, ws + WS_WGLU, MTOK, 768, 768, F.G, bx); S.tA = (size_t)256 * 32;
            pg8::OpDesc dA; dA.rs = 32u; dA.ks = 4u * (unsigned)MTOK * 32u; dA.cshift = 4; dA.cstride = (unsigned)MTOK * 32u;
            EpiGlu E{(const bf16_t*)(ws + WS_YC), KIN(kp, I_BGLU) + l * 768, (bf16_t*)(ws + WS_YC2)};
            pg8::gemm_phase(F.tid, ring, 768, dA, pg8::dense_op(768), S, E); }
            SEAM(pb + 5);
        }
        if (IN(pb + 6)) { PH_BEGIN();
            { pg8::DenseSched S; S.init(ws + WS_YA, ws + WS_WPA, MTOK, DM, 512, F.G, bx);
              EpiMerge<false> E{(const bf16_t*)(ws + WS_GATES), (bf16_t*)(ws + WS_MERGED)};
              pg8::gemm_phase(F.tid, ring, 512, pg8::dense_op(512), pg8::dense_op(512), S, E); }
            PH_REFRESH();
            { pg8::DenseSched S; S.init(ws + WS_YB, ws + WS_WPB, MTOK, DM, 768, F.G, bx);
              EpiMerge<true> E{(const bf16_t*)(ws + WS_GATES) + 2048, (bf16_t*)(ws + WS_MERGED)};
              pg8::gemm_phase(F.tid, ring, 768, pg8::dense_op(768), pg8::dense_op(768), S, E); }
            PH_REFRESH();
            { pg8::DenseSched S; S.init(ws + WS_YC2, ws + WS_WPC, MTOK, DM, 768, F.G, bx);
              EpiMerge<true> E{(const bf16_t*)(ws + WS_GATES) + 4096, (bf16_t*)(ws + WS_MERGED)};
              pg8::gemm_phase(F.tid, ring, 768, pg8::dense_op(768), pg8::dense_op(768), S, E); }
            SEAM(pb + 6);
        }
        if (IN(pb + 7)) { PH_BEGIN();
            pg8::DenseSched S; S.init(ws + WS_MERGED, ws + WS_WO, MTOK, DM, DM, F.G, bx);
            const f32x2* stat = (const f32x2*)(ws + WS_STAT);
            if (l == 0) { EpiResid<false> E{KIN(kp, I_X), KOUT(kp), stat, nullptr, nullptr};
                pg8::gemm_phase(F.tid, ring, DM, pg8::dense_op(DM), pg8::dense_op(DM), S, E); }
            else { EpiResid<true> E{(const float*)KOUT(kp), KOUT(kp), stat, KIN(kp, I_LN2G) + (l - 1) * DM, KIN(kp, I_LN2B) + (l - 1) * DM};
                pg8::gemm_phase(F.tid, ring, DM, pg8::dense_op(DM), pg8::dense_op(DM), S, E); }
            SEAM(pb + 7);
        }
        if (IN(pb + 8)) { PH_BEGIN(); phase_ln(F, kp, KIN(kp, I_LN1G) + l * DM, KIN(kp, I_LN1B) + l * DM, false); SEAM(pb + 8); }
        if (IN(pb + 9)) { PH_BEGIN();
            pg8::DenseSched S; S.init(ws + WS_XB, ws + WS_WFF1, MTOK, 2 * DFF, DM, F.G, bx);
            EpiSwiglu E{(bf16_t*)(ws + WS_H)};
            pg8::gemm_phase(F.tid, ring, DM, pg8::dense_op(DM), pg8::dense_op(DM), S, E);
#if MK_REPEAT == 11
            PH_REFRESH(); asm volatile("" : "+s"(bx)); S.init(ws + WS_XB, ws + WS_WFF1, MTOK, 2 * DFF, DM, F.G, bx);
            pg8::gemm_phase(F.tid, ring, DM, pg8::dense_op(DM), pg8::dense_op(DM), S, E);
#endif
            SEAM(pb + 9);
        }
        if (IN(pb + 10)) { PH_BEGIN();
            pg8::DenseSched S; S.init(ws + WS_H, ws + WS_WFF2, MTOK, DM, DFF, F.G, bx);
            EpiResid<true> E{(const float*)KOUT(kp), KOUT(kp), (const f32x2*)(ws + WS_STAT), KIN(kp, I_LN1G) + l * DM, KIN(kp, I_LN1B) + l * DM};
            pg8::gemm_phase(F.tid, ring, DFF, pg8::dense_op(DFF), pg8::dense_op(DFF), S, E);
            SEAM(pb + 10);
        }
        if (IN(pb + 11)) { PH_BEGIN(); phase_ln(F, kp, KIN(kp, I_LN2G) + l * DM, KIN(kp, I_LN2B) + l * DM, l + 1 == DEPTH); SEAM(pb + 11); }
    }
#undef IN
#undef SEAM
}

extern "C" void kernel_launch(void* const* d_in, const int* in_sizes, int n_in, void* d_out, int out_size, void* d_ws, size_t ws_size, hipStream_t stream) {
    static int grid = 0;
    if (grid == 0) {
        if (n_in != 28 || out_size != MTOK * DM || ws_size < WS_END) { fprintf(stderr, "kernel_launch: unexpected problem (n_in %d, out %d, ws %zu, need %zu)\n", n_in, out_size, ws_size, (size_t)WS_END); grid = -1; return; }
        int dev = 0, cus = 0, per_cu = 0;
        if (hipGetDevice(&dev) != hipSuccess || hipDeviceGetAttribute(&cus, hipDeviceAttributeMultiprocessorCount, dev) != hipSuccess) { grid = -1; return; }
        if (hipFuncSetAttribute((const void*)mk_fwd, hipFuncAttributeMaxDynamicSharedMemorySize, LDS_BYTES) != hipSuccess) { fprintf(stderr, "kernel_launch: hipFuncSetAttribute failed\n"); grid = -1; return; }
        if (hipOccupancyMaxActiveBlocksPerMultiprocessor(&per_cu, (const void*)mk_fwd, NWAVES * 64, LDS_BYTES) != hipSuccess || per_cu < 1) { fprintf(stderr, "kernel_launch: occupancy query says %d\n", per_cu); }
        (void)hipGetLastError();
        grid = cus;
    }
    if (grid < 0) return;
    (void)hipMemsetAsync((char*)d_ws + WS_CTL, 0, CTL_ZERO_BYTES, stream);
    Args a{};
    for (int i = 0; i < 28; ++i) a.in[i] = (const float*)d_in[i];
    a.out = (float*)d_out; a.ws = (unsigned char*)d_ws;
#if MK_MULTI
    for (int p = 0; p < 2 + DEPTH * NPH; ++p) { a.ph_lo = p; a.ph_hi = p + 1; hipLaunchKernelGGL(mk_fwd, dim3(grid), dim3(NWAVES * 64), LDS_BYTES, stream, a); }
#else
    a.ph_lo = 0; a.ph_hi = 2 + DEPTH * NPH;
    hipLaunchKernelGGL(mk_fwd, dim3(grid), dim3(NWAVES * 64), LDS_BYTES, stream, a);
#endif
    const hipError_t le = hipPeekAtLastError();
    if (le != hipSuccess) fprintf(stderr, "kernel_launch: launch failed: %s\n", hipGetErrorName(le));
}
```

```cpp
#include <hip/hip_runtime.h>
#include <cstdio>
#include <cstdint>

#ifndef MK_MULTI
#define MK_MULTI 0
#endif

#ifndef MK_REPEAT
#define MK_REPEAT (-1)
#endif
#define REP(tag) for (int rep_ = 0; rep_ < ((MK_REPEAT) == (tag) ? 2 : 1); ++rep_)
#define GAS __attribute__((address_space(1)))
#define LAS __attribute__((address_space(3)))
typedef unsigned short bf16_t;
typedef short bf16x8 __attribute__((ext_vector_type(8)));
typedef float f32x4 __attribute__((ext_vector_type(4)));
typedef float f32x2 __attribute__((ext_vector_type(2)));
typedef float f32x16 __attribute__((ext_vector_type(16)));
typedef unsigned u32x4 __attribute__((ext_vector_type(4)));
typedef unsigned u32x2 __attribute__((ext_vector_type(2)));

constexpr int DM = 2048, BATCH = 8, SEQ = 4096, DEPTH = 4, MTOK = BATCH * SEQ;
constexpr int NCOLS_IN = 13056, DFF = 5632;
constexpr float ALPHA = 1.681792830507429f;
constexpr float LN_EPS = 1e-5f;
constexpr float LOG2E = 1.4426950408889634f, LN2 = 0.6931471805599453f;
constexpr int NPH = 12;

__device__ const unsigned char T5B[3][129] = {
 {0,1,2,3,4,5,6,7,8,9,10,11,12,13,14,15,16,16,16,16,16,16,17,17,17,17,17,17,17,17,18,18,18,18,18,18,18,18,18,18,19,19,19,19,19,19,19,19,19,19,19,19,19,19,20,20,20,20,20,20,20,20,20,20,20,20,20,20,20,20,20,20,20,21,21,21,21,21,21,21,21,21,21,21,21,21,21,21,21,21,21,21,21,21,21,21,21,21,21,22,22,22,22,22,22,22,22,22,22,22,22,22,22,22,22,22,22,22,22,22,22,22,22,22,22,22,22,22,22},
 {0,4,8,12,16,16,17,17,18,18,19,19,19,19,20,20,20,20,20,21,21,21,21,21,21,22,22,22,22,22,22,22,22,22,23,23,23,23,23,23,23,23,23,23,23,23,24,24,24,24,24,24,24,24,24,24,24,24,24,24,24,24,25,25,25,25,25,25,25,25,25,25,25,25,25,25,25,25,25,25,25,25,25,26,26,26,26,26,26,26,26,26,26,26,26,26,26,26,26,26,26,26,26,26,26,26,26,26,26,26,26,26,26,27,27,27,27,27,27,27,27,27,27,27,27,27,27,27,27},
 {0,16,18,19,20,21,21,22,22,23,23,23,24,24,24,24,25,25,25,25,25,26,26,26,26,26,26,26,26,27,27,27,27,27,27,27,27,27,27,28,28,28,28,28,28,28,28,28,28,28,28,28,29,29,29,29,29,29,29,29,29,29,29,29,29,29,29,29,29,29,30,30,30,30,30,30,30,30,30,30,30,30,30,30,30,30,30,30,30,30,30,30,30,30,30,31,31,31,31,31,31,31,31,31,31,31,31,31,31,31,31,31,31,31,31,31,31,31,31,31,31,31,31,31,31,31,31,31,31}};

typedef __bf16 bf16x2_t __attribute__((ext_vector_type(2)));
__device__ __forceinline__ unsigned cvt_pk_bf16(float lo, float hi) { const f32x2 v = {lo, hi}; return __builtin_bit_cast(unsigned, __builtin_convertvector(v, bf16x2_t)); }
__device__ __forceinline__ float bf_lo(unsigned w) { return __uint_as_float(w << 16); }
__device__ __forceinline__ float bf_hi(unsigned w) { return __uint_as_float(w & 0xffff0000u); }
__device__ __forceinline__ float fast_sigmoid(float x) { return __builtin_amdgcn_rcpf(1.0f + __builtin_amdgcn_exp2f(-LOG2E * x)); }
__device__ __forceinline__ float gelu_tanh(float x) {
    const float u = x * (1.0f + 0.044715f * x * x);
    return x * __builtin_amdgcn_rcpf(1.0f + __builtin_amdgcn_exp2f(-2.0f * 0.7978845608028654f * LOG2E * u));
}
__device__ __forceinline__ float silu(float x) { return x * fast_sigmoid(x); }
__device__ __forceinline__ void unpack8(const u32x4 w, float (&f)[8]) {
    f[0] = bf_lo(w.x); f[1] = bf_hi(w.x); f[2] = bf_lo(w.y); f[3] = bf_hi(w.y); f[4] = bf_lo(w.z); f[5] = bf_hi(w.z); f[6] = bf_lo(w.w); f[7] = bf_hi(w.w);
}
__device__ __forceinline__ u32x4 pack8(const float (&f)[8]) {
    u32x4 w; w.x = cvt_pk_bf16(f[0], f[1]); w.y = cvt_pk_bf16(f[2], f[3]); w.z = cvt_pk_bf16(f[4], f[5]); w.w = cvt_pk_bf16(f[6], f[7]); return w;
}
__device__ __forceinline__ float shfl_xor_l(float v, int o, int lane) { return __int_as_float(__builtin_amdgcn_ds_bpermute((lane ^ o) << 2, __float_as_int(v))); }
__device__ __forceinline__ float wave_sum(float v, int lane) {
#pragma unroll
    for (int o = 1; o < 64; o <<= 1) v += shfl_xor_l(v, o, lane);
    return v;
}

namespace pg8 {
constexpr int BM = 256, BK = 64, HALF = 128, HTB = HALF * BK * 2, STAGE_BYTES = 8 * HTB, NXCD = 8, WGM = 4;
__host__ __device__ __forceinline__ int lds_byte(int r, int c) { const int st = (r >> 4) * 2 + (c >> 5), rr = r & 15, cc = c & 31, ob = rr * 64 + cc * 2; return st * 1024 + (ob ^ (((ob >> 9) & 1) << 5)); }
__host__ __device__ __forceinline__ void stage_rc(int b, int& R, int& C) { const int st = b / 1024, sb = b % 1024, swz = sb ^ (((sb >> 9) & 1) << 5); R = (st >> 1) * 16 + swz / 64; C = (st & 1) * 32 + (swz % 64) / 2; }
__host__ __device__ __forceinline__ int perm32(int rho) { const int n = rho >> 4, i = rho & 15; return 8 * (i >> 2) + 4 * n + (i & 3); }

struct Unit { int pm, pn, g; };
struct OpDesc { unsigned rs, ks; int cshift; unsigned cstride; };
__device__ __forceinline__ OpDesc dense_op(int K) { OpDesc d; d.rs = (unsigned)K * 2u; d.ks = 128u; d.cshift = 6; d.cstride = 0u; return d; }
__device__ __forceinline__ unsigned op_off(const OpDesc& d, int R, int C) { return (unsigned)R * d.rs + (unsigned)(C >> d.cshift) * d.cstride + (unsigned)(C & ((1 << d.cshift) - 1)) * 2u; }

template <class Epi, class Sched>
__device__ __forceinline__ void gemm_phase(const int tid_in, LAS unsigned char* lds, const int K, const OpDesc dA, const OpDesc dB, const Sched& S, const Epi& E) {
    int tid = tid_in; asm volatile("" : "+v"(tid));
    const int wid = __builtin_amdgcn_readfirstlane(tid >> 6), lane = tid & 63, wr = wid >> 2, wc = wid & 3, fr = lane & 15, fq = lane >> 4;
    unsigned voffA[2], voffB[2];
#pragma unroll
    for (int i = 0; i < 2; ++i) { int R, C; stage_rc(tid * 16 + i * 8192, R, C); const int Rb = Epi::PERM ? ((R & ~31) + perm32(R & 31)) : R;
        voffA[i] = op_off(dA, R, C); voffB[i] = op_off(dB, Rb, C); }
    const size_t kstepA = dA.ks, kstepB = dB.ks;
    const size_t hstepA = (size_t)HALF * dA.rs, hstepB = (size_t)HALF * dB.rs;
    const unsigned ldsw = (unsigned)wid * 1024u;
    const int aoff = lds_byte(wr * 64 + fr, fq * 8), boff = lds_byte(wc * 32 + fr, fq * 8);
#define PG8_SA(b, h) (((b) * 2 + (h)) * HTB)
#define PG8_SB(b, h) ((4 + (b) * 2 + (h)) * HTB)
#define PG8_STAGE(bufoff, gbase, voff) do { _Pragma("unroll") for (int _i = 0; _i < 2; ++_i) \
        __builtin_amdgcn_global_load_lds((const unsigned*)((const char*)(gbase) + (voff)[_i]), (LAS unsigned*)(lds + (bufoff) + ldsw + _i * 8192), 16, 0, 0); } while (0)
#define PG8_LDA(dst, b, h) do { _Pragma("unroll") for (int m = 0; m < 4; ++m) _Pragma("unroll") for (int k = 0; k < 2; ++k) dst[m][k] = *(const LAS bf16x8*)(lds + PG8_SA(b, h) + aoff + m * 2048 + k * 1024); } while (0)
#define PG8_LDB(dst, b, h) do { _Pragma("unroll") for (int n = 0; n < 2; ++n) _Pragma("unroll") for (int k = 0; k < 2; ++k) dst[n][k] = *(const LAS bf16x8*)(lds + PG8_SB(b, h) + boff + n * 2048 + k * 1024); } while (0)
#define PG8_MMA(ai, bj, At, Bt) do { __builtin_amdgcn_s_setprio(1); _Pragma("unroll") for (int m = 0; m < 4; ++m) _Pragma("unroll") for (int n = 0; n < 2; ++n) _Pragma("unroll") for (int k = 0; k < 2; ++k) \
        acc[ai][bj][m][n] = __builtin_amdgcn_mfma_f32_16x16x32_bf16(Bt[n][k], At[m][k], acc[ai][bj][m][n], 0, 0, 0); __builtin_amdgcn_s_setprio(0); } while (0)
#define PG8_WAIT_V(n) asm volatile("s_waitcnt vmcnt(" #n ")" ::: "memory")
#define PG8_WAIT_L(n) asm volatile("s_waitcnt lgkmcnt(" #n ")" ::: "memory")
#define PG8_BAR __builtin_amdgcn_s_barrier()
#define PG8_SCHED __builtin_amdgcn_sched_barrier(0)
    Unit cur, nxt; int ui = 0;
    if (!S.next(0, cur)) return;
    f32x4 acc[2][2][4][2];
#pragma unroll
    for (int a = 0; a < 2; ++a)
#pragma unroll
        for (int b = 0; b < 2; ++b)
#pragma unroll
            for (int m = 0; m < 4; ++m)
#pragma unroll
                for (int n = 0; n < 2; ++n) acc[a][b][m][n] = (f32x4){0.f, 0.f, 0.f, 0.f};
    bf16x8 At[4][2], B0[2][2], B1[2][2];
    const char* cA = S.pA(cur); const char* cB = S.pB(cur);
    PG8_STAGE(PG8_SB(0, 0), cB, voffB); PG8_STAGE(PG8_SB(0, 1), cB + hstepB, voffB); PG8_STAGE(PG8_SA(0, 0), cA, voffA); PG8_STAGE(PG8_SA(0, 1), cA + hstepA, voffA);
    if (wr == 1) PG8_BAR;
    PG8_WAIT_V(2); PG8_BAR;
    PG8_STAGE(PG8_SB(1, 0), cB + kstepB, voffB); PG8_STAGE(PG8_SA(1, 0), cA + kstepA, voffA); PG8_STAGE(PG8_SB(1, 1), cB + hstepB + kstepB, voffB);
    PG8_WAIT_V(6); PG8_BAR;
    for (;;) {
        const int nt = S.ntiles(cur, K / BK);
        const bool has_next = S.next(ui + 1, nxt);
        const char* nA = has_next ? S.pA(nxt) : cA; const char* nB = has_next ? S.pB(nxt) : cB;
        for (int t = 0; t < nt; t += 2) {
            const bool last = (t == nt - 2);
            const char* a1 = cA + (size_t)(t + 1) * kstepA;
            const char* a2 = last ? nA : cA + (size_t)(t + 2) * kstepA; const char* b2 = last ? nB : cB + (size_t)(t + 2) * kstepB;
            const char* a3 = a2 + kstepA; const char* b3 = b2 + kstepB;
            PG8_LDB(B0, 0, 0); PG8_LDB(B1, 0, 1); PG8_SCHED; PG8_LDA(At, 0, 0); PG8_STAGE(PG8_SA(1, 1), a1 + hstepA, voffA);
            PG8_WAIT_V(8); PG8_WAIT_L(0); PG8_BAR; PG8_MMA(0, 0, At, B0); PG8_MMA(0, 1, At, B1); PG8_BAR; PG8_SCHED;
            PG8_LDA(At, 0, 1); PG8_STAGE(PG8_SB(0, 0), b2, voffB); PG8_STAGE(PG8_SB(0, 1), b2 + hstepB, voffB); PG8_STAGE(PG8_SA(0, 0), a2, voffA);
            PG8_WAIT_V(8); PG8_WAIT_L(0); PG8_BAR; PG8_MMA(1, 0, At, B0); PG8_MMA(1, 1, At, B1); PG8_BAR; PG8_SCHED;
            PG8_LDB(B0, 1, 0); PG8_LDB(B1, 1, 1); PG8_SCHED; PG8_LDA(At, 1, 0); PG8_STAGE(PG8_SA(0, 1), a2 + hstepA, voffA);
            PG8_WAIT_V(8); PG8_WAIT_L(0); PG8_BAR; PG8_MMA(0, 0, At, B0); PG8_MMA(0, 1, At, B1); PG8_BAR; PG8_SCHED;
            PG8_LDA(At, 1, 1); PG8_STAGE(PG8_SB(1, 0), b3, voffB); PG8_STAGE(PG8_SB(1, 1), b3 + hstepB, voffB); PG8_STAGE(PG8_SA(1, 0), a3, voffA);
            PG8_WAIT_V(8); PG8_WAIT_L(0); PG8_BAR; PG8_MMA(1, 0, At, B0); PG8_MMA(1, 1, At, B1); PG8_BAR; PG8_SCHED;
        }
        if (wr == 0) PG8_BAR;
        E(acc, cur, wr, wc, fr, fq);
        if (!has_next) break;
#pragma unroll
        for (int a = 0; a < 2; ++a)
#pragma unroll
            for (int b = 0; b < 2; ++b)
#pragma unroll
                for (int m = 0; m < 4; ++m)
#pragma unroll
                    for (int n = 0; n < 2; ++n) acc[a][b][m][n] = (f32x4){0.f, 0.f, 0.f, 0.f};
        cur = nxt; cA = nA; cB = nB; ++ui;
        if (wr == 1) PG8_BAR;
    }
    PG8_WAIT_V(0);
    PG8_BAR;
#undef PG8_SA
#undef PG8_SB
#undef PG8_STAGE
#undef PG8_LDA
#undef PG8_LDB
#undef PG8_MMA
#undef PG8_WAIT_V
#undef PG8_WAIT_L
#undef PG8_BAR
#undef PG8_SCHED
}

struct DenseSched {
    int nM, nN, nwg, G, c; const char* A; const char* B; size_t tA, tB;
    __device__ void init(const void* A_, const void* B_, int M, int N, int K, int G_, int c_) { nM = M / BM; nN = N / BM; nwg = nM * nN; G = G_; c = c_; A = (const char*)A_; B = (const char*)B_; tA = (size_t)BM * K * 2; tB = tA; }
    __device__ bool next(int i, Unit& u) const {
        const long L = (long)i * G + c; if (L >= nwg) return false;
        int wgid = (int)L; { const int q = nwg / NXCD, r = nwg % NXCD, xcd = wgid % NXCD, off = wgid / NXCD; wgid = (xcd < r ? xcd * (q + 1) : r * (q + 1) + (xcd - r) * q) + off; }
        const int nig = WGM * nN, gid = wgid / nig, fm = gid * WGM, gsz = (nM - fm) < WGM ? (nM - fm) : WGM;
        u.pm = fm + ((wgid % nig) % gsz); u.pn = (wgid % nig) / gsz; u.g = 0; return true;
    }
    __device__ __forceinline__ const char* pA(const Unit& u) const { return A + (size_t)u.pm * tA; }
    __device__ __forceinline__ const char* pB(const Unit& u) const { return B + (size_t)u.pn * tB; }
    __device__ __forceinline__ int ntiles(const Unit&, int full) const { return full; }
};
struct SwapSched {
    int nM, nwg, G, c, dil; const char* W; const char* X;
    __device__ bool next(int i, Unit& u) const { const int L = i * G + c; if (L >= nwg) return false; u.pm = L % nM; u.pn = L / nM; u.g = 0; return true; }
    __device__ __forceinline__ const char* pA(const Unit& u) const { return W + (size_t)u.pm * (256 * DM * 2); }
    __device__ __forceinline__ const char* pB(const Unit& u) const {
        const int b = u.pn >> 4, o = (u.pn & 15) * 256, Ls = SEQ / dil, cc = o / Ls, m0 = o % Ls;
        return X + (size_t)(b * SEQ + m0 * dil + cc) * (DM * 2);
    }
    __device__ __forceinline__ int ntiles(const Unit&, int full) const { return full; }
};
struct GroupSched {
    int nM, nN, nwg, G, c; const char* A; const char* B; size_t gA, tA, gB, tB; int toep;
    __device__ bool next(int i, Unit& u) const { const int L = i * G + c; if (L >= nwg) return false; const int per = nM * nN; u.g = L / per; const int r = L % per; u.pm = r % nM; u.pn = r / nM; return true; }
    __device__ __forceinline__ const char* pA(const Unit& u) const { return A + (size_t)u.g * gA + (size_t)u.pm * tA; }
    __device__ __forceinline__ const char* pB(const Unit& u) const { return B + (size_t)u.g * gB + (size_t)u.pn * tB; }
    __device__ __forceinline__ int ntiles(const Unit& u, int full) const { return (toep && u.pn < 4) ? 4 * u.pn + 4 : full; }
};
}
using pg8::Unit;

constexpr size_t MiB = 1u << 20;
constexpr size_t WS_CTL = 0, CTL_ZERO_BYTES = 1 * MiB;
constexpr size_t WS_WIN  = 1 * MiB;
constexpr size_t WS_WGLU = WS_WIN + (size_t)NCOLS_IN * DM * 2;
constexpr size_t WS_WPA  = WS_WGLU + 768 * 768 * 2;
constexpr size_t WS_WPB  = WS_WPA + 2048 * 512 * 2;
constexpr size_t WS_WPC  = WS_WPB + 2048 * 768 * 2;
constexpr size_t WS_WO   = WS_WPC + 2048 * 768 * 2;
constexpr size_t WS_WFF1 = WS_WO + (size_t)DM * DM * 2;
constexpr size_t WS_WFF2 = WS_WFF1 + (size_t)2 * DFF * DM * 2;
constexpr size_t WS_MISC = WS_WFF2 + (size_t)DM * DFF * 2;
constexpr size_t MS_BIASR = 0;
constexpr size_t MS_WTRIL = 64 * 1024;
constexpr size_t MS_END   = MS_WTRIL + 6 * 128 * 128 * 2;
constexpr size_t WS_S5BT = ((WS_MISC + MS_END + MiB - 1) / MiB) * MiB;
constexpr size_t WS_S5QM = WS_S5BT + (size_t)(48 * 1152 + 128) * 1024 * 2;
constexpr size_t WS_XB   = ((WS_S5QM + (size_t)48 * 1024 * 256 * 2 + MiB - 1) / MiB) * MiB;
constexpr size_t WS_Q    = WS_XB + (size_t)MTOK * DM * 2;
constexpr size_t WS_K    = WS_Q + (size_t)MTOK * 1536 * 2;
constexpr size_t WS_MERGED = WS_Q;
constexpr size_t WS_VT   = WS_K + (size_t)MTOK * 1536 * 2;
constexpr size_t WS_VGT  = WS_VT + (size_t)1536 * MTOK * 2;
constexpr size_t WS_U    = WS_VGT + (size_t)768 * MTOK * 2;
constexpr size_t WS_UC   = WS_U + (size_t)MTOK * 768 * 2;
constexpr size_t WS_GATES = WS_UC + (size_t)MTOK * 768 * 2;
constexpr size_t WS_H    = WS_GATES;
constexpr size_t WS_LSE  = WS_GATES + (size_t)MTOK * 6144 * 2;
constexpr size_t WS_YA   = WS_LSE + (size_t)MTOK * 24 * 4;
constexpr size_t WS_YB   = WS_YA + (size_t)MTOK * 512 * 2;
constexpr size_t WS_YC   = WS_YB + (size_t)MTOK * 768 * 2;
constexpr size_t WS_YC2  = WS_YC + (size_t)MTOK * 768 * 2;
constexpr size_t WS_YI   = WS_YC2 + (size_t)MTOK * 768 * 2;
constexpr size_t WS_E    = WS_YI + (size_t)MTOK * 768 * 2;
constexpr size_t WS_XIN  = WS_E + (size_t)512 * 48 * 128 * 4;
constexpr size_t WS_TAB  = WS_XIN + (size_t)48 * 512 * 256 * 2;
constexpr size_t TAB_PW = 0, TAB_BB = 48 * 64 * 65 * 8, TAB_KJ = TAB_BB + 48 * 64 * 16 * 8, TAB_LAYER = TAB_KJ + 48 * 64 * 256 * 4;
constexpr size_t WS_STAT = WS_TAB + DEPTH * TAB_LAYER;
constexpr size_t WS_END  = WS_STAT + (size_t)MTOK * 8;
static_assert(WS_H + (size_t)MTOK * DFF * 2 <= WS_LSE, "h overlay fits in the gates");
static_assert(WS_MERGED + (size_t)MTOK * DM * 2 <= WS_VT, "merged overlay fits in q|k");

constexpr int CW_TMO = 0, CW_BAR = 4096;
constexpr int RING_OFF = 0, RING_BYTES = 131072, LDSCTL_OFF = RING_BYTES, MISC_OFF = LDSCTL_OFF + 320, LDS_BYTES = 147456;
constexpr int NWAVES = 8;

#define XB_TMO      128
#define XB_XCNT(j)  (256  + 64 * (j))
#define XB_XSUB(j)  (1280 + 64 * (j))
#define XB_XGEN(j)  (2304 + 64 * (j))
#define XB_TOP      3328
#define XB_TOPGEN   3392
#define XCD_BAR_WORDS 3456
#define XB_SPIN_CAP (1u << 18)
__device__ __forceinline__ unsigned xb_ld(unsigned* p)              { return __hip_atomic_load(p, __ATOMIC_RELAXED, __HIP_MEMORY_SCOPE_AGENT); }
__device__ __forceinline__ unsigned xb_add(unsigned* p, unsigned v) { return __hip_atomic_fetch_add(p, v, __ATOMIC_RELAXED, __HIP_MEMORY_SCOPE_AGENT); }
__device__ __forceinline__ unsigned xb_xcc_id() { return (unsigned)__builtin_amdgcn_s_getreg((3 << 11) | 20) & 0xFu; }
#define XB_SPIN(cond, bar) do { unsigned _sp = 0; while (cond) { __builtin_amdgcn_s_sleep(1); \
    if ((++_sp & 255u) == 0u) { if (xb_ld(&(bar)[XB_TMO])) break; if (_sp > XB_SPIN_CAP) { atomicAdd(&(bar)[XB_TMO], 1u); break; } } } } while (0)
struct XcdBarrier { unsigned* bar; unsigned x; volatile LAS unsigned* st; };
__device__ __forceinline__ XcdBarrier xcd_barrier_post(unsigned* bar, volatile LAS unsigned* st) {
    XcdBarrier b; b.bar = bar; b.x = xb_xcc_id(); b.st = st;
    if (threadIdx.x == 0) (void)xb_add(&bar[XB_XCNT(b.x)], 1u);
    return b;
}
__device__ __forceinline__ void xcd_barrier_complete(unsigned* bar, unsigned x, unsigned& nloc, unsigned& nx) {
    const unsigned G = gridDim.x * gridDim.y * gridDim.z;
    unsigned sum, cnt, mine, sp = 0u;
    for (;;) {
        sum = 0u; cnt = 0u; mine = 0u;
#pragma unroll
        for (unsigned j = 0; j < 16; ++j) { const unsigned c = xb_ld(&bar[XB_XCNT(j)]); sum += c; cnt += (c > 0u) ? 1u : 0u; mine = (j == x) ? c : mine; }
        if (sum == G) break;
        __builtin_amdgcn_s_sleep(1);
        if ((++sp & 255u) == 0u) { if (xb_ld(&bar[XB_TMO])) break; if (sp > XB_SPIN_CAP) { atomicAdd(&bar[XB_TMO], 1u); break; } }
    }
    nloc = mine > 0u ? mine : 1u; nx = cnt > 0u ? cnt : 1u;
}
__device__ __forceinline__ void xcd_barrier(const XcdBarrier& b, const bool leader  ) {
    asm volatile("s_waitcnt vmcnt(0)" ::: "memory");
    __syncthreads();
    if (leader) {
        unsigned* bar = b.bar;
        __builtin_amdgcn_s_waitcnt(0);
        unsigned nloc = b.st[0], nx = b.st[1];
        if (nloc == 0u) { xcd_barrier_complete(bar, b.x, nloc, nx); b.st[0] = nloc; b.st[1] = nx; }
        const unsigned old = xb_add(&bar[XB_XSUB(b.x)], 1u);
        const unsigned gen = old / nloc;
        if (old + 1u == (gen + 1u) * nloc) {
            __builtin_amdgcn_fence(__ATOMIC_RELEASE, "agent");
            asm volatile("s_waitcnt vmcnt(0)" ::: "memory");
            const unsigned og = xb_add(&bar[XB_TOP], 1u);
            const unsigned tg = og / nx;
            if (og + 1u == (tg + 1u) * nx) xb_add(&bar[XB_TOPGEN], 1u);
            else XB_SPIN(xb_ld(&bar[XB_TOPGEN]) == tg, bar);
            __builtin_amdgcn_fence(__ATOMIC_ACQUIRE, "agent");
            xb_add(&bar[XB_XGEN(b.x)], 1u);
            asm volatile("s_waitcnt vmcnt(0)" ::: "memory");
        } else {
            XB_SPIN(xb_ld(&bar[XB_XGEN(b.x)]) == gen, bar);
            __builtin_amdgcn_fence(__ATOMIC_ACQUIRE, "agent");
            asm volatile("s_waitcnt vmcnt(0)" ::: "memory");
        }
    }
    __syncthreads();
}

struct Args {
    const float* in[28];
    float* out; unsigned char* ws;
    int ph_lo, ph_hi;
};
enum { I_X = 0, I_WIN, I_BIN, I_REL, I_SLNG, I_SLNB, I_WS, I_BS, I_LRE, I_LIM, I_LDT, I_BRE, I_BIM, I_CRE, I_CIM, I_DSK, I_WGLU, I_BGLU, I_WPA, I_WPB, I_WPC, I_WO,
       I_LN1G, I_LN1B, I_WFF1, I_WFF2, I_LN2G, I_LN2B };

typedef const __attribute__((address_space(4))) unsigned char* kptr_t;
#define KIN(kp, i)  ((const float*)(const GAS float*)(*(const float* const __attribute__((address_space(4)))*)((kp) + 8 * (i))))
#define KOUT(kp)    ((float*)(GAS float*)(*(float* const __attribute__((address_space(4)))*)((kp) + 224)))
#define KWS(kp)     ((unsigned char*)(GAS unsigned char*)(*(unsigned char* const __attribute__((address_space(4)))*)((kp) + 232)))
static_assert(sizeof(Args) == 248, "Args layout");

#define EPI_ROWS_BEGIN  _Pragma("unroll") for (int ai = 0; ai < 2; ++ai) _Pragma("unroll") for (int m = 0; m < 4; ++m) { const int rl = ai * 128 + wr * 64 + m * 16 + fr;
#define EPI_ROWS_END    asm volatile("" ::: "memory"); }
#define EPI_LOADV(v, ai, bj, m) float v[8]; { const f32x4 a0 = acc[ai][bj][m][0], a1 = acc[ai][bj][m][1]; v[0] = a0[0]; v[1] = a0[1]; v[2] = a0[2]; v[3] = a0[3]; v[4] = a1[0]; v[5] = a1[1]; v[6] = a1[2]; v[7] = a1[3]; }

struct EpiInProj {
    static constexpr bool PERM = true;
    bf16_t *Q, *Kb, *U, *UC, *G; const float* bias;
    template <int MODE> __device__ __forceinline__ void run(const f32x4 (&acc)[2][2][4][2], bf16_t* base, int ld, int row0, int colt, int bcol0, int wr, int wc, int fr, int fq) const {
        f32x4 bv[2][2];
#pragma unroll
        for (int bj = 0; bj < 2; ++bj)
#pragma unroll
            for (int n = 0; n < 2; ++n) bv[bj][n] = *(const f32x4*)(bias + bcol0 + bj * 128 + 4 * n);
        EPI_ROWS_BEGIN
            bf16_t* rowp = base + (size_t)(row0 + rl) * ld + colt + wc * 32 + 8 * fq;
#pragma unroll
            for (int bj = 0; bj < 2; ++bj) { EPI_LOADV(v, ai, bj, m)
#pragma unroll
                for (int j = 0; j < 8; ++j) { float x = v[j] + bv[bj][j >> 2][j & 3];
                    if (MODE == 0) x *= 0.125f * LOG2E; else if (MODE == 2) x = gelu_tanh(x); else if (MODE == 3) x = fast_sigmoid(x);
                    v[j] = x; }
                __builtin_nontemporal_store(pack8(v), (u32x4*)(rowp + bj * 128)); }
        EPI_ROWS_END
    }
    __device__ __forceinline__ void operator()(const f32x4 (&acc)[2][2][4][2], const Unit& u, int wr, int wc, int fr, int fq) const {
        const int pn = u.pn, row0 = u.pm * 256, bcol0 = pn * 256 + wc * 32 + 8 * fq;
        if (pn < 6) run<0>(acc, Q, 1536, row0, pn * 256, bcol0, wr, wc, fr, fq);
        else if (pn < 12) run<1>(acc, Kb, 1536, row0, (pn - 6) * 256, bcol0, wr, wc, fr, fq);
        else if (pn < 15) run<2>(acc, U, 768, row0, (pn - 12) * 256, bcol0, wr, wc, fr, fq);
        else if (pn < 18) {
            f32x4 bv[2][2];
#pragma unroll
            for (int bj = 0; bj < 2; ++bj)
#pragma unroll
                for (int n = 0; n < 2; ++n) bv[bj][n] = *(const f32x4*)(bias + bcol0 + bj * 128 + 4 * n);
            EPI_ROWS_BEGIN
#pragma unroll
                for (int bj = 0; bj < 2; ++bj) { EPI_LOADV(v, ai, bj, m)
#pragma unroll
                    for (int j = 0; j < 8; ++j) v[j] += bv[bj][j >> 2][j & 3];
                    const int cc = (pn - 15) * 256 + bj * 128 + wc * 32 + 8 * fq;
                    *(u32x4*)(UC + ((size_t)(cc >> 4) * MTOK + row0 + rl) * 16 + (cc & 15)) = pack8(v); }
            EPI_ROWS_END
        }
        else run<3>(acc, G, 6144, row0, (pn - 18) * 256, bcol0, wr, wc, fr, fq);
    }
};
struct EpiSwap {
    static constexpr bool PERM = true;
    bf16_t *VT, *VGT; const float* bias; int nvt;
    __device__ __forceinline__ void operator()(const f32x4 (&acc)[2][2][4][2], const Unit& u, int wr, int wc, int fr, int fq) const {
        const bool isv = u.pm < nvt;
        bf16_t* base = isv ? VT + (size_t)u.pm * 256 * MTOK : VGT + (size_t)(u.pm - nvt) * 256 * MTOK;
        const int col0 = u.pn * 256 + wc * 32 + 8 * fq;
        EPI_ROWS_BEGIN
            const float bs = bias[u.pm * 256 + rl];
            bf16_t* rowp = base + (size_t)rl * MTOK + col0;
#pragma unroll
            for (int bj = 0; bj < 2; ++bj) { EPI_LOADV(v, ai, bj, m)
#pragma unroll
                for (int j = 0; j < 8; ++j) { const float x = v[j] + bs; v[j] = isv ? x : gelu_tanh(x); }
                *(u32x4*)(rowp + bj * 128) = pack8(v); }
        EPI_ROWS_END
    }
};
struct EpiS5A {
    static constexpr bool PERM = true;
    bf16_t* YI; float* E;
    __device__ __forceinline__ void operator()(const f32x4 (&acc)[2][2][4][2], const Unit& u, int wr, int wc, int fr, int fq) const {
        const int n0 = u.pm * 256, g = u.g;
        if (u.pn < 4) {
            EPI_ROWS_BEGIN
#pragma unroll
                for (int bj = 0; bj < 2; ++bj) { EPI_LOADV(v, ai, bj, m)
                    const int col = u.pn * 256 + bj * 128 + wc * 32 + 8 * fq;
                    *(u32x4*)(YI + (size_t)g * MTOK * 16 + (size_t)(n0 + rl) * 1024 + col) = pack8(v); }
            EPI_ROWS_END
        } else {
            EPI_ROWS_BEGIN
                { const int col = wc * 32 + 8 * fq; float* p = E + ((size_t)(n0 + rl) * 48 + g) * 128 + col;
                  *(f32x4*)p = acc[ai][0][m][0]; *(f32x4*)(p + 4) = acc[ai][0][m][1]; }
            EPI_ROWS_END
        }
    }
};
struct EpiS5B {
    static constexpr bool PERM = true;
    const bf16_t* YI; const bf16_t* UC; const float* dsk; bf16_t* YC;
    __device__ __forceinline__ void operator()(const f32x4 (&acc)[2][2][4][2], const Unit& u, int wr, int wc, int fr, int fq) const {
        const int n0 = u.pm * 256, g = u.g;
        EPI_ROWS_BEGIN
#pragma unroll
            for (int bj = 0; bj < 2; ++bj) { EPI_LOADV(v, ai, bj, m)
                const int col = u.pn * 256 + bj * 128 + wc * 32 + 8 * fq, h0 = col & 15;
                const size_t off = (size_t)g * MTOK * 16 + (size_t)(n0 + rl) * 1024 + col;
                float yi[8], uu[8]; unpack8(*(const u32x4*)(YI + off), yi); unpack8(*(const u32x4*)(UC + off), uu);
                const f32x4 d0 = *(const f32x4*)(dsk + g * 16 + h0), d1 = *(const f32x4*)(dsk + g * 16 + h0 + 4);
#pragma unroll
                for (int j = 0; j < 8; ++j) v[j] = gelu_tanh(v[j] + yi[j] + (j < 4 ? d0[j & 3] : d1[j & 3]) * uu[j]);
                *(u32x4*)(YC + off) = pack8(v); }
        EPI_ROWS_END
    }
};
struct EpiGlu {
    static constexpr bool PERM = true;
    const bf16_t* YC; const float* bias; bf16_t* YC2;
    __device__ __forceinline__ void operator()(const f32x4 (&acc)[2][2][4][2], const Unit& u, int wr, int wc, int fr, int fq) const {
        const int col0 = u.pn * 256 + wc * 32 + 8 * fq;
        EPI_ROWS_BEGIN
#pragma unroll
            for (int bj = 0; bj < 2; ++bj) { EPI_LOADV(v, ai, bj, m)
                const int col = col0 + bj * 128; const size_t off = (size_t)(u.pm * 256 + rl) * 768 + col;
                float y[8]; unpack8(*(const u32x4*)(YC + ((size_t)(col >> 4) * MTOK + (size_t)(u.pm * 256 + rl)) * 16 + (col & 15)), y);
                const f32x4 b0 = *(const f32x4*)(bias + col), b1 = *(const f32x4*)(bias + col + 4);
#pragma unroll
                for (int j = 0; j < 8; ++j) v[j] = y[j] * fast_sigmoid(v[j] + (j < 4 ? b0[j & 3] : b1[j & 3]));
                *(u32x4*)(YC2 + off) = pack8(v); }
        EPI_ROWS_END
    }
};
template <bool ACCUM> struct EpiMerge {
    static constexpr bool PERM = true;
    const bf16_t* G; bf16_t* O;
    __device__ __forceinline__ void operator()(const f32x4 (&acc)[2][2][4][2], const Unit& u, int wr, int wc, int fr, int fq) const {
        const int col0 = u.pn * 256 + wc * 32 + 8 * fq;
#pragma unroll
        for (int ai = 0; ai < 2; ++ai) {
            u32x4 gw[4][2], pw[4][2];
#pragma unroll
            for (int m = 0; m < 4; ++m)
#pragma unroll
                for (int bj = 0; bj < 2; ++bj) { const size_t r = (size_t)(u.pm * 256 + ai * 128 + wr * 64 + m * 16 + fr); const int col = col0 + bj * 128;
                    gw[m][bj] = *(const u32x4*)(G + r * 6144 + col); if (ACCUM) pw[m][bj] = *(const u32x4*)(O + r * 2048 + col); }
#pragma unroll
            for (int m = 0; m < 4; ++m)
#pragma unroll
                for (int bj = 0; bj < 2; ++bj) { const size_t r = (size_t)(u.pm * 256 + ai * 128 + wr * 64 + m * 16 + fr); const int col = col0 + bj * 128;
                    EPI_LOADV(v, ai, bj, m)
                    float gt[8]; unpack8(gw[m][bj], gt);
                    if (ACCUM) { float pv[8]; unpack8(pw[m][bj], pv);
#pragma unroll
                        for (int j = 0; j < 8; ++j) v[j] = pv[j] + gt[j] * v[j]; }
                    else {
#pragma unroll
                        for (int j = 0; j < 8; ++j) v[j] = gt[j] * v[j]; }
                    *(u32x4*)(O + r * 2048 + col) = pack8(v); }
            asm volatile("" ::: "memory");
        }
    }
};
template <bool LN> struct EpiResid {
    static constexpr bool PERM = false;
    const float* xres; float* out; const f32x2* stat; const float* lng; const float* lnb; bf16_t* yb;
    __device__ __forceinline__ void operator()(const f32x4 (&acc)[2][2][4][2], const Unit& u, int wr, int wc, int fr, int fq) const {
        const int col0 = u.pn * 256 + wc * 32 + 4 * fq;
        f32x4 gv[2][2], bv[2][2];
        if (LN) {
#pragma unroll
            for (int bj = 0; bj < 2; ++bj)
#pragma unroll
                for (int n = 0; n < 2; ++n) { gv[bj][n] = *(const f32x4*)(lng + col0 + bj * 128 + n * 16); bv[bj][n] = *(const f32x4*)(lnb + col0 + bj * 128 + n * 16); }
        }
#pragma unroll
        for (int h2 = 0; h2 < 4; ++h2) {
            const int ai = h2 >> 1, m0 = (h2 & 1) * 2;
            f32x4 xr[2][2][2]; f32x2 st[2];
#pragma unroll
            for (int mm = 0; mm < 2; ++mm) { const size_t row = (size_t)(u.pm * 256 + ai * 128 + wr * 64 + (m0 + mm) * 16 + fr), off = row * DM + col0;
                st[mm] = (f32x2){0.f, 1.f}; if (LN) st[mm] = stat[row];
#pragma unroll
                for (int bj = 0; bj < 2; ++bj)
#pragma unroll
                    for (int n = 0; n < 2; ++n) xr[mm][bj][n] = *(const f32x4*)(xres + off + bj * 128 + n * 16); }
#pragma unroll
            for (int mm = 0; mm < 2; ++mm) { const size_t row = (size_t)(u.pm * 256 + ai * 128 + wr * 64 + (m0 + mm) * 16 + fr), off = row * DM + col0;
#pragma unroll
                for (int bj = 0; bj < 2; ++bj)
#pragma unroll
                    for (int n = 0; n < 2; ++n) { f32x4 x = xr[mm][bj][n];
                        if (LN) x = (x - st[mm].x) * st[mm].y * gv[bj][n] + bv[bj][n];
                        const f32x4 y = x * ALPHA + acc[ai][bj][m0 + mm][n];
                        *(f32x4*)(out + off + bj * 128 + n * 16) = y;
                        u32x2 w; w.x = cvt_pk_bf16(y[0], y[1]); w.y = cvt_pk_bf16(y[2], y[3]); *(u32x2*)(yb + off + bj * 128 + n * 16) = w; } }
            asm volatile("" ::: "memory");
        }
    }
};
struct EpiSwiglu {
    static constexpr bool PERM = true;
    bf16_t* H;
    __device__ __forceinline__ void operator()(const f32x4 (&acc)[2][2][4][2], const Unit& u, int wr, int wc, int fr, int fq) const {
        const int col0 = u.pn * 128 + wc * 32 + 8 * fq;
        EPI_ROWS_BEGIN
            { EPI_LOADV(gv, ai, 0, m) EPI_LOADV(uv, ai, 1, m)
#pragma unroll
              for (int j = 0; j < 8; ++j) gv[j] = silu(gv[j]) * uv[j];
              __builtin_nontemporal_store(pack8(gv), (u32x4*)(H + (size_t)(u.pm * 256 + rl) * DFF + col0)); }
        EPI_ROWS_END
    }
};

struct Frame {
    LAS unsigned char* lds;
    int tid, lane, wave, vcu, G;
};

__device__ __forceinline__ void transpose_item(const float* W, int K, int N, bf16_t* WT, int k0, int n0s, int n0d, LAS float* scr, int lane) {
    float wv[32];
#pragma unroll
    for (int i = 0; i < 32; ++i) wv[i] = W[(size_t)(k0 + 2 * i + (lane >> 5)) * N + n0s + (lane & 31)];
#pragma unroll
    for (int i = 0; i < 32; ++i) scr[(2 * i + (lane >> 5)) * 33 + (lane & 31)] = wv[i];
    asm volatile("s_waitcnt lgkmcnt(0)" ::: "memory");
    const int c = lane & 7;
#pragma unroll
    for (int j = 0; j < 4; ++j) { const int n = (lane >> 3) + 8 * j; const LAS float* s = scr + (8 * c) * 33 + n;
        u32x4 o; o.x = cvt_pk_bf16(s[0 * 33], s[1 * 33]); o.y = cvt_pk_bf16(s[2 * 33], s[3 * 33]); o.z = cvt_pk_bf16(s[4 * 33], s[5 * 33]); o.w = cvt_pk_bf16(s[6 * 33], s[7 * 33]);
        *(u32x4*)(WT + (size_t)(n0d + n) * K + k0 + 8 * c) = o; }
    asm volatile("s_waitcnt lgkmcnt(0)" ::: "memory");
}
__device__ __forceinline__ int inproj_src_col(int d) {
    if (d < 3072) return d;
    if (d < 3840) return 4608 + (d - 3072);
    if (d < 4608) return 6144 + (d - 3840);
    if (d < 10752) return 6912 + (d - 4608);
    if (d < 11264) return 3072 + (d - 10752);
    if (d < 12032) return 5376 + (d - 11264);
    return 3072 + 512 + (d - 12032);
}
__device__ __forceinline__ int ff1_src_col(int d) { const int pn = d >> 8, w = d & 255; return (w < 128) ? (128 * pn + w) : (DFF + 128 * pn + (w - 128)); }

__device__ __forceinline__ void phase_convert(const Frame& F, kptr_t kp, int l) {
    unsigned char* ws = KWS(kp);
    LAS float* scr = (LAS float*)(F.lds + RING_OFF + F.wave * 16384);
    const int gw = F.vcu * NWAVES + F.wave, NGW = F.G * NWAVES;
    constexpr int I_IN = (DM / 64) * (NCOLS_IN / 32), I_GLU = (768 / 64) * (768 / 32), I_PA = (512 / 64) * (DM / 32), I_PB = (768 / 64) * (DM / 32), I_O = (DM / 64) * (DM / 32),
                  I_F1 = (DM / 64) * (2 * DFF / 32), I_F2 = (DFF / 64) * (DM / 32);
    constexpr int NITEMS = I_IN + I_GLU + I_PA + 2 * I_PB + I_O + I_F1 + I_F2;
    for (int it = gw; it < NITEMS; it += NGW) {
        int r = it;
        if (r < I_IN) { const int nb = NCOLS_IN / 32, kb = r / nb, n0d = (r % nb) * 32; transpose_item(KIN(kp, I_WIN) + (size_t)l * DM * NCOLS_IN, DM, NCOLS_IN, (bf16_t*)(ws + WS_WIN), kb * 64, inproj_src_col(n0d), n0d, scr, F.lane); continue; } r -= I_IN;
        if (r < I_GLU) { const int nb = 768 / 32, kb = r / nb, n0 = (r % nb) * 32; transpose_item(KIN(kp, I_WGLU) + (size_t)l * 768 * 768, 768, 768, (bf16_t*)(ws + WS_WGLU), kb * 64, n0, n0, scr, F.lane); continue; } r -= I_GLU;
        if (r < I_PA) { const int nb = DM / 32, kb = r / nb, n0 = (r % nb) * 32; transpose_item(KIN(kp, I_WPA) + (size_t)l * 512 * DM, 512, DM, (bf16_t*)(ws + WS_WPA), kb * 64, n0, n0, scr, F.lane); continue; } r -= I_PA;
        if (r < I_PB) { const int nb = DM / 32, kb = r / nb, n0 = (r % nb) * 32; transpose_item(KIN(kp, I_WPB) + (size_t)l * 768 * DM, 768, DM, (bf16_t*)(ws + WS_WPB), kb * 64, n0, n0, scr, F.lane); continue; } r -= I_PB;
        if (r < I_PB) { const int nb = DM / 32, kb = r / nb, n0 = (r % nb) * 32; transpose_item(KIN(kp, I_WPC) + (size_t)l * 768 * DM, 768, DM, (bf16_t*)(ws + WS_WPC), kb * 64, n0, n0, scr, F.lane); continue; } r -= I_PB;
        if (r < I_O) { const int nb = DM / 32, kb = r / nb, n0 = (r % nb) * 32; transpose_item(KIN(kp, I_WO) + (size_t)l * DM * DM, DM, DM, (bf16_t*)(ws + WS_WO), kb * 64, n0, n0, scr, F.lane); continue; } r -= I_O;
        if (r < I_F1) { const int nb = 2 * DFF / 32, kb = r / nb, n0d = (r % nb) * 32; transpose_item(KIN(kp, I_WFF1) + (size_t)l * DM * 2 * DFF, DM, 2 * DFF, (bf16_t*)(ws + WS_WFF1), kb * 64, ff1_src_col(n0d), n0d, scr, F.lane); continue; } r -= I_F1;
        { const int nb = DM / 32, kb = r / nb, n0 = (r % nb) * 32; transpose_item(KIN(kp, I_WFF2) + (size_t)l * DFF * DM, DFF, DM, (bf16_t*)(ws + WS_WFF2), kb * 64, n0, n0, scr, F.lane); }
    }
    const int gt = F.vcu * 512 + F.tid, NGT = F.G * 512;
    if (l == 0) {
        const f32x4* x4 = (const f32x4*)KIN(kp, I_X); u32x2* o = (u32x2*)(ws + WS_XB);
        for (size_t i = gt; i < (size_t)MTOK * DM / 4; i += (size_t)NGT * 8) {
            f32x4 v[8];
#pragma unroll
            for (int j = 0; j < 8; ++j) v[j] = x4[i + (size_t)j * NGT];
#pragma unroll
            for (int j = 0; j < 8; ++j) { u32x2 w; w.x = cvt_pk_bf16(v[j][0], v[j][1]); w.y = cvt_pk_bf16(v[j][2], v[j][3]); o[i + (size_t)j * NGT] = w; } }
    }
    { float* br = (float*)(ws + WS_MISC + MS_BIASR); const float* b = KIN(kp, I_BIN) + (size_t)l * NCOLS_IN;
      for (int i = gt; i < NCOLS_IN; i += NGT) br[i] = b[inproj_src_col(i)]; }
    { bf16_t* wt = (bf16_t*)(ws + WS_MISC + MS_WTRIL); const float* w = KIN(kp, I_WS) + (size_t)l * 6 * 128 * 128;
      for (int i = gt; i < 6 * 128 * 128 / 2; i += NGT) { const int e = 2 * i, t = (e >> 7) & 127, s = e & 127; const float w0 = (s <= t) ? w[e] : 0.f, w1 = (s + 1 <= t) ? w[e + 1] : 0.f; ((unsigned*)wt)[i] = cvt_pk_bf16(w0, w1); } }
}
__device__ __forceinline__ void phase_tables(const Frame& F, kptr_t kp) {
    unsigned char* ws = KWS(kp);
    const int gt0 = F.vcu * 512 + F.tid;
    if (gt0 < DEPTH * 48 * 64) {
        const int l = gt0 / 3072, gt = gt0 % 3072;
        const int g = gt >> 6;
        const double dt = exp((double)KIN(kp, I_LDT)[l * 48 + g]);
        const double lr = (double)KIN(kp, I_LRE)[(size_t)l * 3072 + gt], li = (double)KIN(kp, I_LIM)[(size_t)l * 3072 + gt];
        const double mag = exp(lr * dt), ang = li * dt;
        const double abr = mag * cos(ang), abi = mag * sin(ang);
        const double nrm = lr * lr + li * li;
        const double cr = ((abr - 1.0) * lr + abi * li) / nrm, ci = (abi * lr - (abr - 1.0) * li) / nrm;
        f32x2* BB = (f32x2*)(ws + WS_TAB + (size_t)l * TAB_LAYER + TAB_BB) + (size_t)gt * 16;
        const float* bre = KIN(kp, I_BRE) + ((size_t)l * 3072 + gt) * 16; const float* bim = KIN(kp, I_BIM) + ((size_t)l * 3072 + gt) * 16;
        for (int h = 0; h < 16; ++h) { const double br_ = bre[h], bi_ = bim[h]; BB[h] = (f32x2){(float)(cr * br_ - ci * bi_), (float)(cr * bi_ + ci * br_)}; }
        f32x2* PW = (f32x2*)(ws + WS_TAB + (size_t)l * TAB_LAYER + TAB_PW) + (size_t)gt * 65;
        double pr = 1.0, pi = 0.0;
        for (int j = 0; j <= 64; ++j) { PW[j] = (f32x2){(float)pr, (float)pi}; const double nr = pr * abr - pi * abi, ni = pr * abi + pi * abr; pr = nr; pi = ni; }
    }
}
__device__ __forceinline__ void phase_kj(const Frame& F, kptr_t kp) {
    unsigned char* ws = KWS(kp);
    const int gt = F.vcu * 512 + F.tid, NGT = F.G * 512;
    for (int i = gt; i < DEPTH * 48 * 16 * 64; i += NGT) {
        const int j = i & 63, hp = (i >> 6) & 15, g = (i >> 10) % 48, l = (i >> 10) / 48;
        const f32x2* PW = (const f32x2*)(ws + WS_TAB + (size_t)l * TAB_LAYER + TAB_PW); const f32x2* BB = (const f32x2*)(ws + WS_TAB + (size_t)l * TAB_LAYER + TAB_BB);
        const float* cre = KIN(kp, I_CRE) + ((size_t)l * 48 + g) * 16 * 64 + hp * 64; const float* cim = KIN(kp, I_CIM) + ((size_t)l * 48 + g) * 16 * 64 + hp * 64;
        float acc[16];
#pragma unroll
        for (int h = 0; h < 16; ++h) acc[h] = 0.f;
        for (int p = 0; p < 64; ++p) {
            const float c_r = cre[p], c_i = cim[p]; const f32x2 pw = PW[(size_t)(g * 64 + p) * 65 + j];
            const float wr_ = c_r * pw.x - c_i * pw.y, wi_ = c_r * pw.y + c_i * pw.x;
            const f32x4* bb = (const f32x4*)(BB + (size_t)(g * 64 + p) * 16);
#pragma unroll
            for (int h2 = 0; h2 < 8; ++h2) { const f32x4 b = bb[h2]; acc[2 * h2] += wr_ * b[0] - wi_ * b[1]; acc[2 * h2 + 1] += wr_ * b[2] - wi_ * b[3]; }
        }
        f32x4* o = (f32x4*)((float*)(ws + WS_TAB + (size_t)l * TAB_LAYER + TAB_KJ) + (((size_t)g * 64 + j) * 16 + hp) * 16);
#pragma unroll
        for (int h4 = 0; h4 < 4; ++h4) o[h4] = (f32x4){acc[4 * h4], acc[4 * h4 + 1], acc[4 * h4 + 2], acc[4 * h4 + 3]};
    }
}
__device__ __forceinline__ void phase_s5mats(const Frame& F, kptr_t kp, int l) {
    unsigned char* ws = KWS(kp);
    const int gt = F.vcu * 512 + F.tid, NGT = F.G * 512;
    const f32x2* PW = (const f32x2*)(ws + WS_TAB + (size_t)l * TAB_LAYER + TAB_PW); const f32x2* BB = (const f32x2*)(ws + WS_TAB + (size_t)l * TAB_LAYER + TAB_BB);
    const float* KJ = (const float*)(ws + WS_TAB + (size_t)l * TAB_LAYER + TAB_KJ);
    bf16_t* BT = (bf16_t*)(ws + WS_S5BT);
    for (int i = gt; i < 48 * 1152 * 128; i += NGT) {
        const int ch = i & 127, row = (i >> 7) % 1152, g = (i >> 7) / 1152;
        const int k0 = ch * 8, s = k0 >> 4, h0 = k0 & 15;
        float v[8];
        if (row < 1024) {
            const int t = row >> 4, hp = row & 15;
            if (s >= (t & ~15) + 16) continue;
            if (s <= t) { const float* kq = KJ + (((size_t)g * 64 + (t - s)) * 16 + hp) * 16 + h0; const f32x4 k0v = *(const f32x4*)kq, k1v = *(const f32x4*)(kq + 4);
                v[0] = k0v[0]; v[1] = k0v[1]; v[2] = k0v[2]; v[3] = k0v[3]; v[4] = k1v[0]; v[5] = k1v[1]; v[6] = k1v[2]; v[7] = k1v[3]; }
            else {
#pragma unroll
                for (int j = 0; j < 8; ++j) v[j] = 0.f; }
        } else {
            const int r2 = row - 1024, ri = r2 >> 6, p = r2 & 63;
            const f32x2 pw = PW[(size_t)(g * 64 + p) * 65 + (63 - s)];
#pragma unroll
            for (int j = 0; j < 8; ++j) { const f32x2 bb = BB[(size_t)(g * 64 + p) * 16 + h0 + j]; v[j] = ri ? (pw.x * bb.y + pw.y * bb.x) : (pw.x * bb.x - pw.y * bb.y); }
        }
        *(u32x4*)(BT + ((size_t)g * 1152 + row) * 1024 + k0) = pack8(v);
    }
    const float* cre = KIN(kp, I_CRE) + (size_t)l * 48 * 16 * 64; const float* cim = KIN(kp, I_CIM) + (size_t)l * 48 * 16 * 64;
    bf16_t* QM = (bf16_t*)(ws + WS_S5QM);
    for (int i = gt; i < 48 * 1024 * 32; i += NGT) {
        const int ch = i & 31, row = (i >> 5) & 1023, g = i >> 15;
        const int t = row >> 4, hp = row & 15, k0 = ch * 8;
        float v[8];
        if (k0 < 128) {
            const int ri = k0 >> 6, p0 = k0 & 63;
#pragma unroll
            for (int j = 0; j < 8; ++j) { const int p = p0 + j; const float c_r = cre[(g * 16 + hp) * 64 + p], c_i = cim[(g * 16 + hp) * 64 + p]; const f32x2 pw = PW[(size_t)(g * 64 + p) * 65 + t + 1];
                v[j] = ri ? -(c_r * pw.y + c_i * pw.x) : (c_r * pw.x - c_i * pw.y); }
        } else {
#pragma unroll
            for (int j = 0; j < 8; ++j) v[j] = 0.f;
        }
        *(u32x4*)(QM + ((size_t)g * 1024 + row) * 256 + k0) = pack8(v);
    }
}

constexpr int ATT_KROW = 144, ATT_VROW = 776;
constexpr int ATT_K_OFF = 0, ATT_V_OFF = 384 * ATT_KROW, ATT_TAB_OFF = ATT_V_OFF + 64 * ATT_VROW;
static_assert(ATT_TAB_OFF + 24 * 192 * 4 <= RING_BYTES, "attention LDS map");
__device__ __forceinline__ void phase_attention(const Frame& F, kptr_t kp, const bool dry) {
    unsigned char* ws = KWS(kp);
    LAS unsigned char* lk = F.lds + RING_OFF + ATT_K_OFF; LAS unsigned char* lv = F.lds + RING_OFF + ATT_V_OFF;
    LAS float* tab = (LAS float*)(F.lds + RING_OFF + ATT_TAB_OFF);
    const float* rel = KIN(kp, I_REL);
    for (int i = F.tid; i < 24 * 192; i += 512) { const int gh = i / 192, idx = i % 192, steps = idx - 31, g = gh >> 3;
        tab[i] = (steps >= 0 && steps <= 128) ? rel[(int)T5B[g][steps] * 24 + gh] * LOG2E : -1.0e30f; }
    bf16_t* Qb = (bf16_t*)(ws + WS_Q); const bf16_t* Kb = (const bf16_t*)(ws + WS_K); const bf16_t* VT = (const bf16_t*)(ws + WS_VT);
    const int lane = F.lane, q = lane & 31, hh = lane >> 5, w = F.wave;
    u32x4 kr[6], vr[6];
#define ATT_DECODE(u_) const int g = (u_) >> 10, r_ = (u_) & 1023, b = r_ >> 7, r2_ = r_ & 127, h = r2_ >> 4, blk8 = r2_ & 15; \
        const int dil = (g == 0) ? 1 : (g == 1 ? 4 : 16), Ls = SEQ / dil, nb8 = Ls / 256; const int c = blk8 / nb8, M0 = (blk8 % nb8) * 256, gh = g * 8 + h;
#define ATT_FETCH(u_) do { ATT_DECODE(u_) \
        _Pragma("unroll") for (int i = 0; i < 6; ++i) { const int idx = F.tid + 512 * i, row = idx >> 3, ch = idx & 7; int pos = M0 - 128 + row; pos = pos < 0 ? 0 : pos; \
            kr[i] = *(const u32x4*)(Kb + ((size_t)b * SEQ + (size_t)pos * dil + c) * 1536 + gh * 64 + ch * 8); } \
        _Pragma("unroll") for (int i = 0; i < 6; ++i) { const int idx = F.tid + 512 * i, dim = idx / 48, ch = idx % 48; int pos = M0 - 128 + ch * 8; pos = pos < 0 ? 0 : pos; \
            vr[i] = *(const u32x4*)(VT + (size_t)(gh * 64 + dim) * MTOK + (size_t)b * SEQ + (size_t)c * Ls + pos); } } while (0)
    if (F.vcu < 3072) ATT_FETCH(F.vcu);
    for (int u = F.vcu; u < 3072; u += F.G) {
        ATT_DECODE(u)
        const size_t tq = (size_t)b * SEQ + (size_t)(M0 + 32 * w + q) * dil + c;
        bf16_t* qrow = Qb + tq * 1536 + gh * 64;
        bf16x8 qf[4];
#pragma unroll
        for (int s = 0; s < 4; ++s) qf[s] = *(const bf16x8*)(qrow + s * 16 + hh * 8);
#pragma unroll
        for (int i = 0; i < 6; ++i) { const int idx = F.tid + 512 * i, row = idx >> 3, ch = idx & 7; *(LAS u32x4*)(lk + row * ATT_KROW + ch * 16) = kr[i]; }
#pragma unroll
        for (int i = 0; i < 6; ++i) { const int idx = F.tid + 512 * i, dim = idx / 48, ch = idx % 48; LAS unsigned char* d = lv + dim * ATT_VROW + ch * 16;
            *(LAS u32x2*)d = (u32x2){vr[i].x, vr[i].y}; *(LAS u32x2*)(d + 8) = (u32x2){vr[i].z, vr[i].w}; }
        if (u + F.G < 3072) ATT_FETCH(u + F.G);
        __syncthreads();
        const int jmin = (M0 == 0 && w < 4) ? 4 - w : 0;
        const LAS float* tb = tab + gh * 192;
        f32x16 sc[5];
        float mx = -3.0e38f;
#pragma unroll
        for (int j = 0; j < 5; ++j) {
            const LAS unsigned char* krow = lk + (32 * w + 32 * j + q) * ATT_KROW + hh * 16;
            f32x16 acc;
#pragma unroll
            for (int i = 0; i < 16; ++i) { const int ki = (i & 3) + 8 * (i >> 2) + 4 * hh; acc[i] = tb[159 + q - 32 * j - ki]; }
            if (j < jmin) {
#pragma unroll
                for (int i = 0; i < 16; ++i) acc[i] = -1.0e30f; }
#pragma unroll
            for (int s = 0; s < 4; ++s) { const bf16x8 kf = *(const LAS bf16x8*)(krow + s * 32); acc = __builtin_amdgcn_mfma_f32_32x32x16_bf16(kf, qf[s], acc, 0, 0, 0); }
#pragma unroll
            for (int i = 0; i < 16; ++i) mx = fmaxf(mx, acc[i]);
            sc[j] = acc;
        }
        mx = fmaxf(mx, shfl_xor_l(mx, 32, lane));
        float den = 0.f;
        f32x16 o0, o1;
#pragma unroll
        for (int i = 0; i < 16; ++i) { o0[i] = 0.f; o1[i] = 0.f; }
#pragma unroll
        for (int j = 0; j < 5; ++j) {
            float p[16];
#pragma unroll
            for (int i = 0; i < 16; ++i) { p[i] = __builtin_amdgcn_exp2f(sc[j][i] - mx); den += p[i]; }
#pragma unroll
            for (int s = 0; s < 2; ++s) {
                union { bf16x8 v; unsigned w4[4]; } pf;
#pragma unroll
                for (int e = 0; e < 4; ++e) pf.w4[e] = cvt_pk_bf16(p[8 * s + 2 * e], p[8 * s + 2 * e + 1]);
#pragma unroll
                for (int d = 0; d < 2; ++d) {
                    const LAS unsigned char* vrow = lv + (d * 32 + q) * ATT_VROW + (32 * w + 32 * j + 16 * s + 4 * hh) * 2;
                    union { bf16x8 v; u32x2 h2[2]; } vf;
                    vf.h2[0] = *(const LAS u32x2*)vrow; vf.h2[1] = *(const LAS u32x2*)(vrow + 16);
                    if (d == 0) o0 = __builtin_amdgcn_mfma_f32_32x32x16_bf16(vf.v, pf.v, o0, 0, 0, 0);
                    else        o1 = __builtin_amdgcn_mfma_f32_32x32x16_bf16(vf.v, pf.v, o1, 0, 0, 0);
                }
            }
        }
        den += shfl_xor_l(den, 32, lane);
        const float rden = 1.0f / den;
        bf16_t* orow = dry ? (bf16_t*)(ws + WS_YC) + tq * 1536 + gh * 64 : qrow;
#pragma unroll
        for (int d = 0; d < 2; ++d)
#pragma unroll
            for (int gq = 0; gq < 4; ++gq) { const f32x16& o = d ? o1 : o0; u32x2 wv; wv.x = cvt_pk_bf16(o[4 * gq] * rden, o[4 * gq + 1] * rden); wv.y = cvt_pk_bf16(o[4 * gq + 2] * rden, o[4 * gq + 3] * rden);
                *(u32x2*)(orow + d * 32 + 8 * gq + 4 * hh) = wv; }
        if (hh == 0 && !dry) ((float*)(ws + WS_LSE))[tq * 24 + gh] = (mx + __builtin_amdgcn_logf(den)) * LN2;
        __syncthreads();
    }
}

__device__ __forceinline__ void phase_gmlp(const Frame& F, kptr_t kp, int l) {
    unsigned char* ws = KWS(kp);
    LAS float* part = (LAS float*)(F.lds + RING_OFF);
    LAS f32x2* stat = (LAS f32x2*)(F.lds + RING_OFF + 32768);
    const bf16_t* VGT = (const bf16_t*)(ws + WS_VGT); const bf16_t* U = (const bf16_t*)(ws + WS_U); bf16_t* YB = (bf16_t*)(ws + WS_YB);
    const bf16_t* WT = (const bf16_t*)(ws + WS_MISC + MS_WTRIL);
    const float* lng = KIN(kp, I_SLNG) + l * 768; const float* lnb = KIN(kp, I_SLNB) + l * 768; const float* bs = KIN(kp, I_BS) + l * 768;
    const int lane = F.lane, q = lane & 31, hh = lane >> 5;
    for (int ck = F.vcu; ck < MTOK / 128; ck += F.G) {
        const size_t tok0 = (size_t)ck * 128;
        { const int t8 = (F.tid & 15) * 8, pt = F.tid >> 4; float sm[8], sq[8];
#pragma unroll
          for (int j = 0; j < 8; ++j) { sm[j] = 0.f; sq[j] = 0.f; }
#pragma unroll 6
          for (int i = 0; i < 24; ++i) { float v[8]; unpack8(*(const u32x4*)(VGT + (size_t)(pt * 24 + i) * MTOK + tok0 + t8), v);
#pragma unroll
              for (int j = 0; j < 8; ++j) { sm[j] += v[j]; sq[j] += v[j] * v[j]; } }
#pragma unroll
          for (int j = 0; j < 8; ++j) { part[(pt * 128 + t8 + j) * 2] = sm[j]; part[(pt * 128 + t8 + j) * 2 + 1] = sq[j]; } }
        __syncthreads();
        if (F.tid < 128) { float s = 0.f, s2 = 0.f;
#pragma unroll 8
            for (int pt = 0; pt < 32; ++pt) { s += part[(pt * 128 + F.tid) * 2]; s2 += part[(pt * 128 + F.tid) * 2 + 1]; }
            const float mean = s * (1.0f / 768.0f), var = fmaxf(s2 * (1.0f / 768.0f) - mean * mean, 0.f);
            stat[F.tid] = (f32x2){mean, 1.0f / sqrtf(var + LN_EPS)}; }
        __syncthreads();
        const int ct = F.wave & 3, tta = (F.wave >> 2) ? 1 : 0, ttb = (F.wave >> 2) ? 2 : 3;
        for (int g = 0; g < 6; ++g) {
            const int cch = g * 128 + ct * 32 + q;
            const float gg = lng[cch], gb = lnb[cch];
            const bf16_t* vrow = VGT + (size_t)cch * MTOK + tok0;
            const bf16_t* wa = WT + ((size_t)g * 128 + tta * 32 + q) * 128; const bf16_t* wb = WT + ((size_t)g * 128 + ttb * 32 + q) * 128;
            f32x16 ca, cb;
#pragma unroll
            for (int i = 0; i < 16; ++i) { ca[i] = 0.f; cb[i] = 0.f; }
#pragma unroll
            for (int ks = 0; ks < 8; ++ks) {
                const int s0 = 16 * ks + 8 * hh;
                float vv[8]; unpack8(*(const u32x4*)(vrow + s0), vv);
#pragma unroll
                for (int j = 0; j < 8; ++j) { const f32x2 st = stat[s0 + j]; vv[j] = (vv[j] - st.x) * st.y * gg + gb; }
                union { bf16x8 v; u32x4 w; } af; af.w = pack8(vv);
                const bf16x8 bfb = *(const bf16x8*)(wb + s0), bfa = *(const bf16x8*)(wa + s0);
                cb = __builtin_amdgcn_mfma_f32_32x32x16_bf16(af.v, bfb, cb, 0, 0, 0);
                ca = __builtin_amdgcn_mfma_f32_32x32x16_bf16(af.v, bfa, ca, 0, 0, 0);
            }
#pragma unroll
            for (int w2 = 0; w2 < 2; ++w2) {
                const int tt = w2 ? ttb : tta; const f32x16& cc = w2 ? cb : ca;
                const int t = tt * 32 + q; const float bsv = bs[g * 128 + t];
                const size_t rowoff = (tok0 + t) * 768 + g * 128 + ct * 32 + 4 * hh;
#pragma unroll
                for (int gq = 0; gq < 4; ++gq) { const u32x2 uw = *(const u32x2*)(U + rowoff + 8 * gq);
                    u32x2 w; w.x = cvt_pk_bf16(bf_lo(uw.x) * (cc[4 * gq] + bsv), bf_hi(uw.x) * (cc[4 * gq + 1] + bsv)); w.y = cvt_pk_bf16(bf_lo(uw.y) * (cc[4 * gq + 2] + bsv), bf_hi(uw.y) * (cc[4 * gq + 3] + bsv));
                    *(u32x2*)(YB + rowoff + 8 * gq) = w; }
            }
        }
        __syncthreads();
    }
}

__device__ __forceinline__ void phase_carry_combine(const Frame& F, kptr_t kp, int l) {
    unsigned char* ws = KWS(kp);
    const int gt = F.vcu * 512 + F.tid, NGT = F.G * 512;
    const f32x2* PW = (const f32x2*)(ws + WS_TAB + (size_t)l * TAB_LAYER + TAB_PW);
    const float* E = (const float*)(ws + WS_E); bf16_t* XIN = (bf16_t*)(ws + WS_XIN);
    for (int i = gt; i < BATCH * 48 * 64; i += NGT) {
        const int p = i & 63, g = (i >> 6) % 48, b = (i >> 6) / 48;
        const f32x2 aT = PW[(size_t)(g * 64 + p) * 65 + 64];
        float xr = 0.f, xi = 0.f;
        for (int c = 0; c < 64; ++c) {
            const int n = b * 64 + c;
            bf16_t* xo = XIN + ((size_t)g * 512 + n) * 256;
            xo[p] = (bf16_t)(cvt_pk_bf16(xr, 0.f) & 0xffffu); xo[64 + p] = (bf16_t)(cvt_pk_bf16(xi, 0.f) & 0xffffu); xo[128 + p] = 0; xo[192 + p] = 0;
            const float er = E[((size_t)n * 48 + g) * 128 + p], ei = E[((size_t)n * 48 + g) * 128 + 64 + p];
            const float nr = aT.x * xr - aT.y * xi + er, ni = aT.x * xi + aT.y * xr + ei; xr = nr; xi = ni;
        }
    }
    const bf16_t* O = (const bf16_t*)(ws + WS_Q); const float* LSE = (const float*)(ws + WS_LSE); bf16_t* YA = (bf16_t*)(ws + WS_YA);
    for (size_t i = gt; i < (size_t)MTOK * 64; i += NGT) {
        const size_t tok = i >> 6; const int h = (int)(i >> 3) & 7, ch = (int)i & 7;
        const float l0 = LSE[tok * 24 + h], l1 = LSE[tok * 24 + 8 + h], l2 = LSE[tok * 24 + 16 + h];
        const float mx = fmaxf(l0, fmaxf(l1, l2));
        float w0 = __builtin_amdgcn_exp2f((l0 - mx) * LOG2E), w1 = __builtin_amdgcn_exp2f((l1 - mx) * LOG2E), w2 = __builtin_amdgcn_exp2f((l2 - mx) * LOG2E);
        const float rs = 1.0f / (w0 + w1 + w2); w0 *= rs; w1 *= rs; w2 *= rs;
        float o0[8], o1[8], o2[8];
        unpack8(*(const u32x4*)(O + tok * 1536 + h * 64 + ch * 8), o0); unpack8(*(const u32x4*)(O + tok * 1536 + 512 + h * 64 + ch * 8), o1); unpack8(*(const u32x4*)(O + tok * 1536 + 1024 + h * 64 + ch * 8), o2);
#pragma unroll
        for (int j = 0; j < 8; ++j) o0[j] = w0 * o0[j] + w1 * o1[j] + w2 * o2[j];
        *(u32x4*)(YA + tok * 512 + h * 64 + ch * 8) = pack8(o0);
    }
}

__device__ __forceinline__ void phase_ln(const Frame& F, kptr_t kp, const float* gam, const float* bet, bool final_out) {
    const int gw = F.vcu * NWAVES + F.wave, NGW = F.G * NWAVES;
    bf16_t* XB = (bf16_t*)(KWS(kp) + WS_XB); f32x2* STAT = (f32x2*)(KWS(kp) + WS_STAT);
    if (final_out) {
        for (int r = gw; r < MTOK; r += NGW) {
            f32x4* xr = (f32x4*)(KOUT(kp) + (size_t)r * DM) + F.lane;
            f32x4 v[8]; float s = 0.f;
#pragma unroll
            for (int j = 0; j < 8; ++j) { v[j] = xr[64 * j]; s += (v[j][0] + v[j][1]) + (v[j][2] + v[j][3]); }
            const float mean = wave_sum(s, F.lane) * (1.0f / DM); float s2 = 0.f;
#pragma unroll
            for (int j = 0; j < 8; ++j) { v[j] = v[j] - mean; s2 += (v[j][0] * v[j][0] + v[j][1] * v[j][1]) + (v[j][2] * v[j][2] + v[j][3] * v[j][3]); }
            const float rstd = 1.0f / sqrtf(wave_sum(s2, F.lane) * (1.0f / DM) + LN_EPS);
#pragma unroll
            for (int j = 0; j < 8; ++j) { const f32x4 gg = *((const f32x4*)gam + F.lane + 64 * j), bb = *((const f32x4*)bet + F.lane + 64 * j); xr[64 * j] = v[j] * rstd * gg + bb; }
        }
    } else {
        for (int r = gw; r < MTOK; r += NGW) {
            u32x4* xb = (u32x4*)(XB + (size_t)r * DM) + F.lane;
            float v[4][8]; float s = 0.f;
#pragma unroll
            for (int j = 0; j < 4; ++j) { unpack8(xb[64 * j], v[j]);
#pragma unroll
                for (int i = 0; i < 8; ++i) s += v[j][i]; }
            const float mean = wave_sum(s, F.lane) * (1.0f / DM); float s2 = 0.f;
#pragma unroll
            for (int j = 0; j < 4; ++j)
#pragma unroll
                for (int i = 0; i < 8; ++i) { v[j][i] -= mean; s2 += v[j][i] * v[j][i]; }
            const float rstd = 1.0f / sqrtf(wave_sum(s2, F.lane) * (1.0f / DM) + LN_EPS);
            if (F.lane == 0) STAT[r] = (f32x2){mean, rstd};
#pragma unroll
            for (int j = 0; j < 4; ++j) { const int c0 = 512 * j + 8 * F.lane; const f32x4 g0 = *(const f32x4*)(gam + c0), g1 = *(const f32x4*)(gam + c0 + 4), b0 = *(const f32x4*)(bet + c0), b1 = *(const f32x4*)(bet + c0 + 4);
#pragma unroll
                for (int i = 0; i < 8; ++i) v[j][i] = v[j][i] * rstd * (i < 4 ? g0[i & 3] : g1[i & 3]) + (i < 4 ? b0[i & 3] : b1[i & 3]);
                xb[64 * j] = pack8(v[j]); }
        }
    }
}

__global__ void __launch_bounds__(NWAVES * 64, 2) mk_fwd(Args args) {
    extern __shared__ __attribute__((aligned(16))) unsigned char lds_raw[];
    LAS unsigned char* const lds = (LAS unsigned char*)lds_raw;
    int wave_s = __builtin_amdgcn_readfirstlane((int)threadIdx.x >> 6); asm volatile("" : "+s"(wave_s));
    for (int u = threadIdx.x; u < (LDS_BYTES - LDSCTL_OFF) / 4; u += NWAVES * 64) ((LAS unsigned*)(lds + LDSCTL_OFF))[u] = 0u;
    __syncthreads();
#if MK_MULTI
#define GRID_BAR() do {} while (0)
#else
    (void)xcd_barrier_post((unsigned*)(args.ws + WS_CTL) + CW_BAR, (volatile LAS unsigned*)(lds + MISC_OFF) + 8);
#define GRID_BAR() do { PH_REFRESH(); unsigned* bp_ = (unsigned*)(ws + WS_CTL) + CW_BAR; asm volatile("" : "+s"(bp_)); XcdBarrier b_; b_.bar = bp_; b_.x = xb_xcc_id(); b_.st = (volatile LAS unsigned*)(lds + MISC_OFF) + 8; xcd_barrier(b_, F.tid == 0); } while (0)
#endif
    const int lo = args.ph_lo, hi = args.ph_hi;
#define IN(k) (lo <= (k) && (k) < hi)
#define SEAM(k) do { if (IN((k) + 1)) GRID_BAR(); } while (0)
    LAS unsigned char* const ring = lds + RING_OFF;

#define PH_BEGIN() kptr_t kp = (kptr_t)__builtin_amdgcn_kernarg_segment_ptr(); asm volatile("" : "+s"(kp)); unsigned char* ws = KWS(kp); \
        int bx = (int)blockIdx.x; asm volatile("" : "+s"(bx)); unsigned wz_ = (unsigned)wave_s << 6; asm volatile("" : "+s"(wz_)); int tid_ = (int)__builtin_amdgcn_mbcnt_hi(~0u, __builtin_amdgcn_mbcnt_lo(~0u, wz_)); int G_ = (int)gridDim.x; asm volatile("" : "+s"(G_)); \
        Frame F; F.lds = lds; F.tid = tid_; F.lane = tid_ & 63; F.wave = wave_s; F.G = G_; F.vcu = (G_ % 8 == 0) ? (bx % 8) * (G_ / 8) + bx / 8 : bx;
#define PH_REFRESH() do { unsigned wz2_ = (unsigned)wave_s << 6; asm volatile("" : "+s"(wz2_)); F.tid = (int)__builtin_amdgcn_mbcnt_hi(~0u, __builtin_amdgcn_mbcnt_lo(~0u, wz2_)); F.lane = F.tid & 63; } while (0)
    if (IN(0)) { PH_BEGIN(); phase_tables(F, kp); SEAM(0); }
    if (IN(1)) { PH_BEGIN(); REP(1) phase_kj(F, kp); SEAM(1); }
    for (int l = 0; l < DEPTH; ++l) {
        const int pb = 2 + l * NPH;
        if (IN(pb + 0)) { PH_BEGIN(); REP(0) phase_convert(F, kp, l); REP(2) phase_s5mats(F, kp, l); SEAM(pb + 0); }
        if (IN(pb + 1)) { PH_BEGIN(); REP(3) {
            const float* biasr = (const float*)(ws + WS_MISC + MS_BIASR);
            { pg8::DenseSched S; S.init(ws + WS_XB, ws + WS_WIN, MTOK, 10752, DM, F.G, bx);
              EpiInProj E{(bf16_t*)(ws + WS_Q), (bf16_t*)(ws + WS_K), (bf16_t*)(ws + WS_U), (bf16_t*)(ws + WS_UC), (bf16_t*)(ws + WS_GATES), biasr};
              pg8::gemm_phase(F.tid, ring, DM, pg8::dense_op(DM), pg8::dense_op(DM), S, E); }
            PH_REFRESH();
            { pg8::SwapSched S; S.nM = 5; S.nwg = 5 * 128; S.G = F.G; S.c = bx; S.dil = 1; S.W = (const char*)(ws + WS_WIN) + (size_t)10752 * DM * 2; S.X = (const char*)(ws + WS_XB);
              EpiSwap E{(bf16_t*)(ws + WS_VT), (bf16_t*)(ws + WS_VGT), biasr + 10752, 2};
              pg8::OpDesc dB = pg8::dense_op(DM);
              pg8::gemm_phase(F.tid, ring, DM, pg8::dense_op(DM), dB, S, E); }
            PH_REFRESH();
            { pg8::SwapSched S; S.nM = 2; S.nwg = 2 * 128; S.G = F.G; S.c = bx; S.dil = 4; S.W = (const char*)(ws + WS_WIN) + (size_t)12032 * DM * 2; S.X = (const char*)(ws + WS_XB);
              EpiSwap E{(bf16_t*)(ws + WS_VT) + (size_t)512 * MTOK, (bf16_t*)(ws + WS_VGT), biasr + 12032, 2};
              pg8::OpDesc dB = pg8::dense_op(DM); dB.rs = 4u * DM * 2u;
              pg8::gemm_phase(F.tid, ring, DM, pg8::dense_op(DM), dB, S, E); }
            PH_REFRESH();
            { pg8::SwapSched S; S.nM = 2; S.nwg = 2 * 128; S.G = F.G; S.c = bx; S.dil = 16; S.W = (const char*)(ws + WS_WIN) + (size_t)12544 * DM * 2; S.X = (const char*)(ws + WS_XB);
              EpiSwap E{(bf16_t*)(ws + WS_VT) + (size_t)1024 * MTOK, (bf16_t*)(ws + WS_VGT), biasr + 12544, 2};
              pg8::OpDesc dB = pg8::dense_op(DM); dB.rs = 16u * DM * 2u;
              pg8::gemm_phase(F.tid, ring, DM, pg8::dense_op(DM), dB, S, E); }
            PH_REFRESH(); }
            SEAM(pb + 1);
        }
        if (IN(pb + 2)) { PH_BEGIN();
            REP(40) { PH_REFRESH(); pg8::GroupSched S; S.nM = 2; S.nN = 5; S.nwg = 480; S.G = F.G; S.c = bx; S.toep = 1;
              S.A = (const char*)(ws + WS_UC); S.gA = (size_t)MTOK * 16 * 2; S.tA = (size_t)256 * 1024 * 2;
              S.B = (const char*)(ws + WS_S5BT); S.gB = (size_t)1152 * 1024 * 2; S.tB = (size_t)256 * 1024 * 2;
              EpiS5A E{(bf16_t*)(ws + WS_YI), (float*)(ws + WS_E)};
              pg8::gemm_phase(F.tid, ring, 1024, pg8::dense_op(1024), pg8::dense_op(1024), S, E); }
            PH_REFRESH();
            REP(41) phase_gmlp(F, kp, l);
            if ((MK_REPEAT) == 42) phase_attention(F, kp, true);
            phase_attention(F, kp, false);
            SEAM(pb + 2);
        }
        if (IN(pb + 3)) { PH_BEGIN(); REP(5) phase_carry_combine(F, kp, l); SEAM(pb + 3); }
        if (IN(pb + 4)) { PH_BEGIN(); REP(6) { PH_REFRESH();
            pg8::GroupSched S; S.nM = 2; S.nN = 4; S.nwg = 384; S.G = F.G; S.c = bx; S.toep = 0;
            S.A = (const char*)(ws + WS_XIN); S.gA = (size_t)512 * 256 * 2; S.tA = (size_t)256 * 256 * 2;
            S.B = (const char*)(ws + WS_S5QM); S.gB = (size_t)1024 * 256 * 2; S.tB = (size_t)256 * 256 * 2;
            EpiS5B E{(const bf16_t*)(ws + WS_YI), (const bf16_t*)(ws + WS_UC), KIN(kp, I_DSK) + l * 768, (bf16_t*)(ws + WS_YC)};
            pg8::gemm_phase(F.tid, ring, 256, pg8::dense_op(256), pg8::dense_op(256), S, E); }
            SEAM(pb + 4);
        }
        if (IN(pb + 5)) { PH_BEGIN(); REP(7) { PH_REFRESH();
            pg8::DenseSched S; S.init(ws + WS_YC, ws + WS_WGLU, MTOK, 768, 768, F.G, bx); S.tA = (size_t)256 * 32;
            pg8::OpDesc dA; dA.rs = 32u; dA.ks = 4u * (unsigned)MTOK * 32u; dA.cshift = 4; dA.cstride = (unsigned)MTOK * 32u;
            EpiGlu E{(const bf16_t*)(ws + WS_YC), KIN(kp, I_BGLU) + l * 768, (bf16_t*)(ws + WS_YC2)};
            pg8::gemm_phase(F.tid, ring, 768, dA, pg8::dense_op(768), S, E); }
            SEAM(pb + 5);
        }
        if (IN(pb + 6)) { PH_BEGIN();
            { pg8::DenseSched S; S.init(ws + WS_YA, ws + WS_WPA, MTOK, DM, 512, F.G, bx);
              EpiMerge<false> E{(const bf16_t*)(ws + WS_GATES), (bf16_t*)(ws + WS_MERGED)};
              pg8::gemm_phase(F.tid, ring, 512, pg8::dense_op(512), pg8::dense_op(512), S, E); }
            PH_REFRESH();
            { pg8::DenseSched S; S.init(ws + WS_YB, ws + WS_WPB, MTOK, DM, 768, F.G, bx);
              EpiMerge<true> E{(const bf16_t*)(ws + WS_GATES) + 2048, (bf16_t*)(ws + WS_MERGED)};
              pg8::gemm_phase(F.tid, ring, 768, pg8::dense_op(768), pg8::dense_op(768), S, E); }
            PH_REFRESH();
            { pg8::DenseSched S; S.init(ws + WS_YC2, ws + WS_WPC, MTOK, DM, 768, F.G, bx);
              EpiMerge<true> E{(const bf16_t*)(ws + WS_GATES) + 4096, (bf16_t*)(ws + WS_MERGED)};
              pg8::gemm_phase(F.tid, ring, 768, pg8::dense_op(768), pg8::dense_op(768), S, E); }
            SEAM(pb + 6);
        }
#if MK_REPEAT == 8
        if (IN(pb + 6)) { PH_BEGIN();
            { pg8::DenseSched S; S.init(ws + WS_YA, ws + WS_WPA, MTOK, DM, 512, F.G, bx);
              EpiMerge<false> E{(const bf16_t*)(ws + WS_GATES), (bf16_t*)(ws + WS_MERGED)};
              pg8::gemm_phase(F.tid, ring, 512, pg8::dense_op(512), pg8::dense_op(512), S, E); }
            PH_REFRESH();
            { pg8::DenseSched S; S.init(ws + WS_YB, ws + WS_WPB, MTOK, DM, 768, F.G, bx);
              EpiMerge<true> E{(const bf16_t*)(ws + WS_GATES) + 2048, (bf16_t*)(ws + WS_MERGED)};
              pg8::gemm_phase(F.tid, ring, 768, pg8::dense_op(768), pg8::dense_op(768), S, E); }
            PH_REFRESH();
            { pg8::DenseSched S; S.init(ws + WS_YC2, ws + WS_WPC, MTOK, DM, 768, F.G, bx);
              EpiMerge<true> E{(const bf16_t*)(ws + WS_GATES) + 4096, (bf16_t*)(ws + WS_MERGED)};
              pg8::gemm_phase(F.tid, ring, 768, pg8::dense_op(768), pg8::dense_op(768), S, E); }
            GRID_BAR();
        }
#endif
        if (IN(pb + 7)) { PH_BEGIN();
            pg8::DenseSched S; S.init(ws + WS_MERGED, ws + WS_WO, MTOK, DM, DM, F.G, bx);
            const f32x2* stat = (const f32x2*)(ws + WS_STAT);
            if (l == 0) { EpiResid<false> E{KIN(kp, I_X), KOUT(kp), stat, nullptr, nullptr, (bf16_t*)(ws + WS_XB)};
                pg8::gemm_phase(F.tid, ring, DM, pg8::dense_op(DM), pg8::dense_op(DM), S, E); }
            else { EpiResid<true> E{(const float*)KOUT(kp), KOUT(kp), stat, KIN(kp, I_LN2G) + (l - 1) * DM, KIN(kp, I_LN2B) + (l - 1) * DM, (bf16_t*)(ws + WS_XB)};
                pg8::gemm_phase(F.tid, ring, DM, pg8::dense_op(DM), pg8::dense_op(DM), S, E); }
            SEAM(pb + 7);
        }
#if MK_REPEAT == 9
        if (IN(pb + 7)) { PH_BEGIN(); GRID_BAR();
            pg8::DenseSched S; S.init(ws + WS_MERGED, ws + WS_WO, MTOK, DM, DM, F.G, bx);
            EpiResid<true> E{(const float*)KOUT(kp), (float*)(ws + WS_GATES), (const f32x2*)(ws + WS_STAT), KIN(kp, I_LN2G), KIN(kp, I_LN2B), (bf16_t*)(ws + WS_VGT)};
            pg8::gemm_phase(F.tid, ring, DM, pg8::dense_op(DM), pg8::dense_op(DM), S, E);
        }
#endif
        if (IN(pb + 8)) { PH_BEGIN(); phase_ln(F, kp, KIN(kp, I_LN1G) + l * DM, KIN(kp, I_LN1B) + l * DM, false); SEAM(pb + 8); }
        if (IN(pb + 9)) { PH_BEGIN();
            pg8::DenseSched S; S.init(ws + WS_XB, ws + WS_WFF1, MTOK, 2 * DFF, DM, F.G, bx);
            EpiSwiglu E{(bf16_t*)(ws + WS_H)};
            pg8::gemm_phase(F.tid, ring, DM, pg8::dense_op(DM), pg8::dense_op(DM), S, E);
            SEAM(pb + 9);
        }
        if (IN(pb + 10)) { PH_BEGIN();
            pg8::DenseSched S; S.init(ws + WS_H, ws + WS_WFF2, MTOK, DM, DFF, F.G, bx);
            EpiResid<true> E{(const float*)KOUT(kp), KOUT(kp), (const f32x2*)(ws + WS_STAT), KIN(kp, I_LN1G) + l * DM, KIN(kp, I_LN1B) + l * DM, (bf16_t*)(ws + WS_XB)};
            pg8::gemm_phase(F.tid, ring, DFF, pg8::dense_op(DFF), pg8::dense_op(DFF), S, E);
            SEAM(pb + 10);
        }
#if MK_REPEAT == 11
        if (IN(pb + 9)) { PH_BEGIN(); GRID_BAR();
            pg8::DenseSched S; S.init(ws + WS_XB, ws + WS_WFF1, MTOK, 2 * DFF, DM, F.G, bx);
            EpiSwiglu E{(bf16_t*)(ws + WS_H)};
            pg8::gemm_phase(F.tid, ring, DM, pg8::dense_op(DM), pg8::dense_op(DM), S, E);
        }
#endif
#if MK_REPEAT == 12
        if (IN(pb + 10)) { PH_BEGIN(); GRID_BAR();
            pg8::DenseSched S; S.init(ws + WS_H, ws + WS_WFF2, MTOK, DM, DFF, F.G, bx);
            EpiResid<true> E{(const float*)KOUT(kp), (float*)(ws + WS_Q), (const f32x2*)(ws + WS_STAT), KIN(kp, I_LN1G) + l * DM, KIN(kp, I_LN1B) + l * DM, (bf16_t*)(ws + WS_VGT)};
            pg8::gemm_phase(F.tid, ring, DFF, pg8::dense_op(DFF), pg8::dense_op(DFF), S, E);
        }
#endif
        if (IN(pb + 11)) { PH_BEGIN(); phase_ln(F, kp, KIN(kp, I_LN2G) + l * DM, KIN(kp, I_LN2B) + l * DM, l + 1 == DEPTH); SEAM(pb + 11); }
    }
#undef IN
#undef SEAM
}

extern "C" void kernel_launch(void* const* d_in, const int* in_sizes, int n_in, void* d_out, int out_size, void* d_ws, size_t ws_size, hipStream_t stream) {
    static int grid = 0;
    if (grid == 0) {
        if (n_in != 28 || out_size != MTOK * DM || ws_size < WS_END) { fprintf(stderr, "kernel_launch: unexpected problem (n_in %d, out %d, ws %zu, need %zu)\n", n_in, out_size, ws_size, (size_t)WS_END); grid = -1; return; }
        int dev = 0, cus = 0, per_cu = 0;
        if (hipGetDevice(&dev) != hipSuccess || hipDeviceGetAttribute(&cus, hipDeviceAttributeMultiprocessorCount, dev) != hipSuccess) { grid = -1; return; }
        if (hipFuncSetAttribute((const void*)mk_fwd, hipFuncAttributeMaxDynamicSharedMemorySize, LDS_BYTES) != hipSuccess) { fprintf(stderr, "kernel_launch: hipFuncSetAttribute failed\n"); grid = -1; return; }
        if (hipOccupancyMaxActiveBlocksPerMultiprocessor(&per_cu, (const void*)mk_fwd, NWAVES * 64, LDS_BYTES) != hipSuccess || per_cu < 1) { fprintf(stderr, "kernel_launch: occupancy query says %d\n", per_cu); }
        (void)hipGetLastError();
        grid = cus;
    }
    if (grid < 0) return;
    (void)hipMemsetAsync((char*)d_ws + WS_CTL, 0, CTL_ZERO_BYTES, stream);
    Args a{};
    for (int i = 0; i < 28; ++i) a.in[i] = (const float*)d_in[i];
    a.out = (float*)d_out; a.ws = (unsigned char*)d_ws;
#if MK_MULTI
    for (int p = 0; p < 2 + DEPTH * NPH; ++p) { a.ph_lo = p; a.ph_hi = p + 1; hipLaunchKernelGGL(mk_fwd, dim3(grid), dim3(NWAVES * 64), LDS_BYTES, stream, a); }
#else
    a.ph_lo = 0; a.ph_hi = 2 + DEPTH * NPH;
    hipLaunchKernelGGL(mk_fwd, dim3(grid), dim3(NWAVES * 64), LDS_BYTES, stream, a);
#endif
    const hipError_t le = hipPeekAtLastError();
    if (le != hipSuccess) fprintf(stderr, "kernel_launch: launch failed: %s\n", hipGetErrorName(le));
}
```
